# Optimizing an MI355X kernel written in HIP

```python
import jax, jax.numpy as jnp
from jax import lax
import numpy as np

D_MODEL = 1024
BATCH = 4
SEQ = 8192
DEPTH = 1

GDN_HEADS = 4
GDN_HEAD_DIM = 128
GDN_WIDTH = GDN_HEADS * GDN_HEAD_DIM
GDN_CHUNK = 64
LRU_WIDTH = D_MODEL // 2
LRU_BLOCKS = 8
LRU_BLOCK = LRU_WIDTH // LRU_BLOCKS
LRU_C = 8.0
CONV_WIDTH = 4
N_EXPERTS = 32
TOP_K = 4
D_FF = D_MODEL
SWIGLU_ALPHA = 1.702
SWIGLU_LIMIT = 7.0
MOE_BLOCK = 256
EPS = 1e-6

IN_SPLITS = (GDN_WIDTH, GDN_WIDTH, GDN_WIDTH, GDN_WIDTH, GDN_HEADS, GDN_HEADS,
             LRU_WIDTH, LRU_WIDTH, D_MODEL, D_MODEL)
D_IN = sum(IN_SPLITS)

kernel_name = 'hybrid_gdn_rglru_moe_block'


def rms_norm(x, gain):
    xf = x.astype(jnp.float32)
    y = xf * lax.rsqrt(jnp.mean(xf * xf, axis=-1, keepdims=True) + EPS)
    return (y * gain.astype(jnp.float32)).astype(x.dtype)


def causal_depthwise_conv(x, w):
    return lax.conv_general_dilated(
        x, w[:, None, :].astype(x.dtype), window_strides=(1,),
        padding=[(CONV_WIDTH - 1, 0)], dimension_numbers=('NWC', 'WIO', 'NWC'),
        feature_group_count=x.shape[-1])


def l2_normalize(t):
    return t * lax.rsqrt(jnp.sum(t * t, axis=-1, keepdims=True) + EPS)


def _to_chunks(t):
    b, s, h = t.shape[:3]
    t = t.reshape(b, s // GDN_CHUNK, GDN_CHUNK, h, *t.shape[3:])
    return jnp.moveaxis(t, 3, 1)


def gated_delta_rule(q, k, v, g, beta):
    b, s, h, dk = q.shape
    dv = v.shape[-1]
    q = _to_chunks(q * (dk ** -0.5))
    k = _to_chunks(k)
    v = _to_chunks(v)
    g = _to_chunks(g)
    beta = _to_chunks(beta)
    c = GDN_CHUNK
    incl = jnp.tril(jnp.ones((c, c), bool))
    strict = jnp.tril(jnp.ones((c, c), bool), -1)
    gc = jnp.cumsum(g, axis=-1)
    diff = gc[..., :, None] - gc[..., None, :]
    decay = jnp.where(incl, jnp.exp(jnp.where(incl, diff, 0.0)), 0.0)
    kb = k * beta[..., None]
    a_mat = jnp.where(strict, jnp.einsum('bhncd,bhnsd->bhncs', kb, k) * decay, 0.0)
    eye = jnp.eye(c, dtype=q.dtype)
    t_mat = lax.linalg.triangular_solve(eye + a_mat, jnp.broadcast_to(eye, a_mat.shape),
                                        left_side=True, lower=True, unit_diagonal=True)
    u = jnp.matmul(t_mat, v * beta[..., None])
    w = jnp.matmul(t_mat, kb * jnp.exp(gc)[..., None])
    qk = jnp.where(incl, jnp.einsum('bhncd,bhnsd->bhncs', q, k) * decay, 0.0)
    q_dec = q * jnp.exp(gc)[..., None]
    k_dec = k * jnp.exp(gc[..., -1:] - gc)[..., None]
    g_last = jnp.exp(gc[..., -1])
    xs = tuple(jnp.moveaxis(t, 2, 0) for t in (w, u, q_dec, k_dec, qk, g_last))

    def step(state, inp):
        w_c, u_c, qd_c, kd_c, qk_c, gl_c = inp
        v_new = u_c - jnp.einsum('bhcd,bhde->bhce', w_c, state)
        o_c = (jnp.einsum('bhcd,bhde->bhce', qd_c, state)
               + jnp.einsum('bhcs,bhse->bhce', qk_c, v_new))
        state = state * gl_c[..., None, None] + jnp.einsum('bhcd,bhce->bhde', kd_c, v_new)
        return state, o_c

    state0 = jnp.zeros((b, h, dk, dv), q.dtype)
    _, o = lax.scan(step, state0, xs)
    return jnp.transpose(o, (1, 0, 3, 2, 4)).reshape(b, s, h, dv)


def gdn_branch(q, k, v, z, b_in, a_in, conv_w, a_log, dt_bias, norm_w):
    bsz, s, _ = q.shape
    qkv = jax.nn.silu(causal_depthwise_conv(jnp.concatenate([q, k, v], axis=-1), conv_w))
    q, k, v = jnp.split(qkv, 3, axis=-1)
    heads = lambda t: t.reshape(bsz, s, GDN_HEADS, GDN_HEAD_DIM).astype(jnp.float32)
    q = l2_normalize(heads(q))
    k = l2_normalize(heads(k))
    v = heads(v)
    beta = jax.nn.sigmoid(b_in.astype(jnp.float32))
    g = -jnp.exp(a_log.astype(jnp.float32)) * jax.nn.softplus(
        a_in.astype(jnp.float32) + dt_bias.astype(jnp.float32))
    o = gated_delta_rule(q, k, v, g, beta)
    o = (o * lax.rsqrt(jnp.mean(o * o, axis=-1, keepdims=True) + EPS)
         * norm_w.astype(jnp.float32) * jax.nn.silu(heads(z)))
    return o.reshape(bsz, s, GDN_WIDTH).astype(q_dtype_of(z))


def q_dtype_of(t):
    return t.dtype


def rglru_branch(xb, yb, conv_w, conv_b, w_a, b_a, w_x, b_x, lam):
    bsz, s, _ = xb.shape
    xc = causal_depthwise_conv(xb, conv_w) + conv_b
    xblk = xc.reshape(bsz, s, LRU_BLOCKS, LRU_BLOCK)
    r = jax.nn.sigmoid((jnp.einsum('bsnc,ncd->bsnd', xblk, w_a).reshape(bsz, s, LRU_WIDTH)
                        + b_a).astype(jnp.float32))
    i = jax.nn.sigmoid((jnp.einsum('bsnc,ncd->bsnd', xblk, w_x).reshape(bsz, s, LRU_WIDTH)
                        + b_x).astype(jnp.float32))
    log_a = -LRU_C * r * jax.nn.softplus(-lam.astype(jnp.float32))
    a = jnp.exp(log_a)
    mult = jnp.sqrt(jnp.maximum(-jnp.expm1(2.0 * log_a), 0.0))
    bterm = mult * (i * xc.astype(jnp.float32))

    def combine(left, right):
        a_l, b_l = left
        a_r, b_r = right
        return a_l * a_r, a_r * b_l + b_r

    _, hseq = lax.associative_scan(combine, (a, bterm), axis=1)
    y = hseq * jax.nn.gelu(yb.astype(jnp.float32))
    return y.astype(xb.dtype)


def swiglu_clamped(u):
    u_glu = jnp.minimum(u[..., ::2], SWIGLU_LIMIT)
    u_lin = jnp.clip(u[..., 1::2], -SWIGLU_LIMIT, SWIGLU_LIMIT)
    return u_glu * jax.nn.sigmoid(SWIGLU_ALPHA * u_glu) * (u_lin + 1.0)


def moe_ffn(h, w_router, b_router, w1, b1, w2, b2):
    bsz, s, d = h.shape
    n_tok = bsz * s
    hf = h.reshape(n_tok, d)
    logits = hf.astype(jnp.float32) @ w_router.astype(jnp.float32) + b_router.astype(jnp.float32)
    top_val, top_idx = lax.top_k(logits, TOP_K)
    gate = jax.nn.softmax(top_val, axis=-1)
    n_assign = n_tok * TOP_K
    flat_e = top_idx.reshape(-1).astype(jnp.int32)
    flat_tok = jnp.arange(n_assign, dtype=jnp.int32) // TOP_K
    flat_w = gate.reshape(-1)
    order = jnp.argsort(flat_e)
    sorted_e = flat_e[order]
    counts = jnp.bincount(flat_e, length=N_EXPERTS)
    padded = (counts + MOE_BLOCK - 1) // MOE_BLOCK * MOE_BLOCK
    start = jnp.cumsum(counts) - counts
    pstart = jnp.cumsum(padded) - padded
    dest = pstart[sorted_e] + jnp.arange(n_assign, dtype=jnp.int32) - start[sorted_e]
    n_blocks = -(-n_assign // MOE_BLOCK) + N_EXPERTS
    n_slots = n_blocks * MOE_BLOCK
    slot_tok = jnp.full((n_slots,), n_tok, jnp.int32).at[dest].set(flat_tok[order])
    slot_w = jnp.zeros((n_slots,), h.dtype).at[dest].set(flat_w[order].astype(h.dtype))
    block_e = jnp.minimum(
        jnp.searchsorted(jnp.cumsum(padded), jnp.arange(n_blocks) * MOE_BLOCK, side='right'),
        N_EXPERTS - 1)
    h_pad = jnp.concatenate([hf, jnp.zeros((1, d), h.dtype)], axis=0)
    xs = h_pad[slot_tok].reshape(n_blocks, MOE_BLOCK, d)

    def expert_block(args):
        xblk, e = args
        u = xblk @ w1[e] + b1[e]
        return swiglu_clamped(u) @ w2[e] + b2[e]

    ys = lax.map(expert_block, (xs, block_e)).reshape(n_slots, d)
    out = jnp.zeros((n_tok + 1, d), h.dtype).at[slot_tok].add(ys * slot_w[:, None])
    return out[:n_tok].reshape(bsz, s, d)


def setup_inputs(seed: int = 0) -> dict:
    key = jax.random.key(seed)
    ks = jax.random.split(key, 32)
    f32 = jnp.float32
    nrm = lambda k, shape, scale: jax.random.normal(k, shape, f32) * scale
    L, D, E, F = DEPTH, D_MODEL, N_EXPERTS, D_FF
    a_init = jax.random.uniform(ks[8], (L, GDN_HEADS), f32, 1.0, 16.0)
    dt = jnp.exp(jax.random.uniform(ks[9], (L, GDN_HEADS), f32, float(np.log(1e-3)), float(np.log(0.1))))
    a_pow = jax.random.uniform(ks[17], (L, LRU_WIDTH), f32, 0.9, 0.999)
    a_lru = a_pow ** (1.0 / LRU_C)
    return {
        'x': nrm(ks[0], (BATCH, SEQ, D), 1.0),
        'c': nrm(ks[1], (BATCH, D), 1.0),
        'w_ada': nrm(ks[2], (L, D, 6 * D), D ** -0.5),
        'b_ada': nrm(ks[3], (L, 6 * D), 0.01),
        'norm_mix': 1.0 + nrm(ks[4], (L, D), 0.01),
        'norm_ffn': 1.0 + nrm(ks[5], (L, D), 0.01),
        'w_in': nrm(ks[6], (L, D, D_IN), D ** -0.5),
        'gdn_conv_w': nrm(ks[7], (L, CONV_WIDTH, 3 * GDN_WIDTH), CONV_WIDTH ** -0.5),
        'gdn_a_log': jnp.log(a_init),
        'gdn_dt_bias': dt + jnp.log(-jnp.expm1(-dt)),
        'gdn_norm_w': 1.0 + nrm(ks[10], (L, GDN_HEAD_DIM), 0.01),
        'lru_conv_w': nrm(ks[11], (L, CONV_WIDTH, LRU_WIDTH), CONV_WIDTH ** -0.5),
        'lru_conv_b': nrm(ks[12], (L, LRU_WIDTH), 0.01),
        'lru_w_a': nrm(ks[13], (L, LRU_BLOCKS, LRU_BLOCK, LRU_BLOCK), LRU_BLOCK ** -0.5),
        'lru_b_a': nrm(ks[14], (L, LRU_WIDTH), 0.01),
        'lru_w_x': nrm(ks[15], (L, LRU_BLOCKS, LRU_BLOCK, LRU_BLOCK), LRU_BLOCK ** -0.5),
        'lru_b_x': nrm(ks[16], (L, LRU_WIDTH), 0.01),
        'lru_lambda': jnp.log(a_lru) - jnp.log1p(-a_lru),
        'w_branch_gdn': nrm(ks[18], (L, GDN_WIDTH, D), GDN_WIDTH ** -0.5),
        'w_branch_lru': nrm(ks[19], (L, LRU_WIDTH, D), LRU_WIDTH ** -0.5),
        'w_out': nrm(ks[20], (L, D, D), D ** -0.5),
        'w_router': nrm(ks[21], (L, D, E), D ** -0.5),
        'b_router': nrm(ks[22], (L, E), 0.01),
        'w1': nrm(ks[23], (L, E, D, 2 * F), D ** -0.5),
        'b1': nrm(ks[24], (L, E, 2 * F), 0.01),
        'w2': nrm(ks[25], (L, E, F, D), F ** -0.5),
        'b2': nrm(ks[26], (L, E, D), 0.01),
        'norm_final': 1.0 + nrm(ks[27], (D,), 0.01),
    }


def reference(x, c, w_ada, b_ada, norm_mix, norm_ffn, w_in, gdn_conv_w, gdn_a_log, gdn_dt_bias,
              gdn_norm_w, lru_conv_w, lru_conv_b, lru_w_a, lru_b_a, lru_w_x, lru_b_x, lru_lambda,
              w_branch_gdn, w_branch_lru, w_out, w_router, b_router, w1, b1, w2, b2, norm_final):
    split_pts = tuple(int(p) for p in np.cumsum(IN_SPLITS)[:-1])
    c_act = jax.nn.silu(c)
    for l in range(DEPTH):
        mod = c_act @ w_ada[l] + b_ada[l]
        shift_m, scale_m, gate_m, shift_f, scale_f, gate_f = [
            m[:, None, :] for m in jnp.split(mod, 6, axis=-1)]
        h = rms_norm(x, norm_mix[l]) * (1.0 + scale_m) + shift_m
        proj = h @ w_in[l]
        q, k, v, z, b_in, a_in, xb, yb, g_gdn, g_lru = jnp.split(proj, split_pts, axis=-1)
        o_gdn = gdn_branch(q, k, v, z, b_in, a_in, gdn_conv_w[l], gdn_a_log[l], gdn_dt_bias[l],
                           gdn_norm_w[l])
        o_lru = rglru_branch(xb, yb, lru_conv_w[l], lru_conv_b[l], lru_w_a[l], lru_b_a[l],
                             lru_w_x[l], lru_b_x[l], lru_lambda[l])
        merged = (jax.nn.sigmoid(g_gdn) * (o_gdn @ w_branch_gdn[l])
                  + jax.nn.sigmoid(g_lru) * (o_lru @ w_branch_lru[l]))
        x = x + gate_m * (merged @ w_out[l])
        h = rms_norm(x, norm_ffn[l]) * (1.0 + scale_f) + shift_f
        x = x + gate_f * moe_ffn(h, w_router[l], b_router[l], w1[l], b1[l], w2[l], b2[l])
    return rms_norm(x, norm_final)
```

```cpp
#include <hip/hip_runtime.h>
#include <cstdio>
#include <cstdint>

#ifndef PROBE_EPI
#define PROBE_EPI 0
#endif
#ifndef PROBE_SUB
#define PROBE_SUB 0
#endif
#ifndef MK_N_LAUNCHES
#define MK_N_LAUNCHES 1
#endif

namespace pg8 {
#define PG8_LAS __attribute__((address_space(3)))
typedef unsigned short bf16_t;
typedef short bf16x8 __attribute__((ext_vector_type(8)));
typedef float f32x4 __attribute__((ext_vector_type(4)));
typedef float f32x2 __attribute__((ext_vector_type(2)));
typedef unsigned u32x4 __attribute__((ext_vector_type(4)));
typedef unsigned u32x2 __attribute__((ext_vector_type(2)));
constexpr int BM = 256, BK = 64, HALF = 128, HTB = HALF * BK * 2, STAGE_BYTES = 8 * HTB, NXCD = 8, WGM = 4;

__host__ __device__ __forceinline__ int lds_byte(int r, int c) { const int st = (r >> 4) * 2 + (c >> 5), rr = r & 15, cc = c & 31, ob = rr * 64 + cc * 2; return st * 1024 + (ob ^ (((ob >> 9) & 1) << 5)); }
__host__ __device__ __forceinline__ void stage_rc(int b, int& R, int& C) { const int st = b / 1024, sb = b % 1024, swz = sb ^ (((sb >> 9) & 1) << 5); R = (st >> 1) * 16 + swz / 64; C = (st & 1) * 32 + (swz % 64) / 2; }
__host__ __device__ __forceinline__ int perm32(int rho) { const int n = rho >> 4, i = rho & 15; return 8 * (i >> 2) + 4 * n + (i & 3); }

struct Unit { int pm, pn, aux, nvalid; const char* A; const char* B; const void* tp[3]; };

__device__ __forceinline__ bool tile_map(long L, int nM, int nN, int& pm, int& pn) {
    const int nwg = nM * nN; if (L >= nwg) return false;
    int wgid = (int)L; { const int q = nwg / NXCD, r = nwg % NXCD, xcd = wgid % NXCD, off = wgid / NXCD; wgid = (xcd < r ? xcd * (q + 1) : r * (q + 1) + (xcd - r) * q) + off; }
    const int nig = WGM * nN, gid = wgid / nig, fm = gid * WGM, gsz = (nM - fm) < WGM ? (nM - fm) : WGM;
    pm = fm + ((wgid % nig) % gsz); pn = (wgid % nig) / gsz; return true;
}
__device__ __forceinline__ const char* uptr(const char* p) {
    unsigned long long v = (unsigned long long)p; unsigned lo = __builtin_amdgcn_readfirstlane((unsigned)v), hi = __builtin_amdgcn_readfirstlane((unsigned)(v >> 32));
    return (const char*)(((unsigned long long)hi << 32) | lo);
}
__device__ __forceinline__ unsigned cvt_pk_bf16(float lo, float hi) { unsigned r; asm volatile("v_cvt_pk_bf16_f32 %0, %1, %2" : "=v"(r) : "v"(lo), "v"(hi)); return r; }
__device__ __forceinline__ float bf_lo(unsigned w) { return __builtin_bit_cast(float, w << 16); }
__device__ __forceinline__ float bf_hi(unsigned w) { return __builtin_bit_cast(float, w & 0xffff0000u); }

template <class Epi, class Sched, bool ALIGN_EPI = false, bool GATHER = false, int NTAB = 0>
__device__ __forceinline__ void gemm_phase(PG8_LAS unsigned char* lds, const int K, const Sched& S, const Epi& E, const int tid, PG8_LAS unsigned char* tabs = nullptr) {
    const int wid = __builtin_amdgcn_readfirstlane(tid >> 6), lane = tid & 63, wr = wid >> 2, wc = wid & 3, fr = lane & 15, fq = lane >> 4;
    const int nt = K / BK;
    unsigned voffA[2], voffB[2]; int RlA[2]; unsigned ClA[2];
#pragma unroll
    for (int i = 0; i < 2; ++i) { int R, C; stage_rc(tid * 16 + i * 8192, R, C); const int Rb = Epi::PERM ? ((R & ~31) + perm32(R & 31)) : R;
        voffA[i] = (unsigned)(R * K + C) * 2u; voffB[i] = (unsigned)(Rb * K + C) * 2u; RlA[i] = R; ClA[i] = (unsigned)C * 2u; }
    const size_t kstep = (size_t)(BK * 2);
    const size_t hstep = (size_t)HALF * K * 2;
    const unsigned ldsw = (unsigned)wid * 1024u;
    const int aoff = lds_byte(wr * 64 + fr, fq * 8), boff = lds_byte(wc * 32 + fr, fq * 8);
#define PG8_SA(b, h) (((b) * 2 + (h)) * HTB)
#define PG8_SB(b, h) ((4 + (b) * 2 + (h)) * HTB)
#define PG8_STAGE(bufoff, gbase, voff) do { _Pragma("unroll") for (int _i = 0; _i < 2; ++_i) \
        __builtin_amdgcn_global_load_lds((const unsigned*)((const char*)(gbase) + (voff)[_i]), (PG8_LAS unsigned*)(lds + (bufoff) + ldsw + _i * 8192), 16, 0, 0); } while (0)
#define PG8_STA(bufoff, p, h, vg) do { if constexpr (GATHER) PG8_STAGE(bufoff, p, (vg)[h]); else PG8_STAGE(bufoff, (p) + (h) * hstep, voffA); } while (0)
#define PG8_LDA(dst, b, h) do { _Pragma("unroll") for (int m = 0; m < 4; ++m) _Pragma("unroll") for (int k = 0; k < 2; ++k) dst[m][k] = *(const PG8_LAS bf16x8*)(lds + PG8_SA(b, h) + aoff + m * 2048 + k * 1024); } while (0)
#define PG8_LDB(dst, b, h) do { _Pragma("unroll") for (int n = 0; n < 2; ++n) _Pragma("unroll") for (int k = 0; k < 2; ++k) dst[n][k] = *(const PG8_LAS bf16x8*)(lds + PG8_SB(b, h) + boff + n * 2048 + k * 1024); } while (0)
#define PG8_MMA(ai, bj, At, Bt) do { __builtin_amdgcn_s_setprio(1); _Pragma("unroll") for (int m = 0; m < 4; ++m) _Pragma("unroll") for (int n = 0; n < 2; ++n) _Pragma("unroll") for (int k = 0; k < 2; ++k) \
        acc[ai][bj][m][n] = __builtin_amdgcn_mfma_f32_16x16x32_bf16(Bt[n][k], At[m][k], acc[ai][bj][m][n], 0, 0, 0); __builtin_amdgcn_s_setprio(0); } while (0)
#define PG8_WAIT_V(n) asm volatile("s_waitcnt vmcnt(" #n ")" ::: "memory")
#define PG8_WAIT_L(n) asm volatile("s_waitcnt lgkmcnt(" #n ")" ::: "memory")
#define PG8_BAR __builtin_amdgcn_s_barrier()
#define PG8_SCHED __builtin_amdgcn_sched_barrier(0)
#define PG8_TAB_DMA(u_, ui_) do { if (wid < NTAB) __builtin_amdgcn_global_load_lds((const unsigned*)((const char*)(wid == 0 ? (u_).tp[0] : wid == 1 ? (u_).tp[1] : (u_).tp[2]) + lane * 16), (PG8_LAS unsigned*)(tabs + ((ui_) % 3) * 3072 + wid * 1024), 16, 0, 0); } while (0)
#define PG8_IDS_READ(u_, ui_, vg) do { const PG8_LAS int* ids = (const PG8_LAS int*)(tabs + ((ui_) % 3) * 3072); _Pragma("unroll") for (int _h = 0; _h < 2; ++_h) _Pragma("unroll") for (int _i = 0; _i < 2; ++_i) { const int _row = _h * HALF + RlA[_i]; const int _id = ids[_row]; \
        const unsigned _tok = _row < (u_).nvalid ? (unsigned)(_id >> 2) : 0u; (vg)[_h][_i] = _tok * (unsigned)(K * 2) + ClA[_i]; } } while (0)
    Unit cur, nxt; int ui = 0;
    if (!S.next(0, cur)) return;
    unsigned vG[2][2] = {{0u, 0u}, {0u, 0u}}, vGn[2][2] = {{0u, 0u}, {0u, 0u}};
    if constexpr (NTAB > 0) { PG8_TAB_DMA(cur, 0); PG8_WAIT_V(0); PG8_BAR; asm volatile("" ::: "memory"); }
    if constexpr (GATHER) { PG8_IDS_READ(cur, 0, vG); PG8_WAIT_L(0); PG8_BAR; }
    f32x4 acc[2][2][4][2];
#define PG8_ACC_INIT(ui_) do { \
    if constexpr (Epi::BIAS_INIT) { f32x4 bv_[2][2]; const PG8_LAS float* bp_ = (const PG8_LAS float*)(tabs + ((ui_) % 3) * 3072 + 1024) + wc * 32 + 8 * fq;   \
        _Pragma("unroll") for (int b = 0; b < 2; ++b) _Pragma("unroll") for (int n = 0; n < 2; ++n) bv_[b][n] = *(const PG8_LAS f32x4*)(bp_ + b * 128 + 4 * n); \
        _Pragma("unroll") for (int a = 0; a < 2; ++a) _Pragma("unroll") for (int b = 0; b < 2; ++b) _Pragma("unroll") for (int m = 0; m < 4; ++m) _Pragma("unroll") for (int n = 0; n < 2; ++n) acc[a][b][m][n] = bv_[b][n]; } \
    else { _Pragma("unroll") for (int a = 0; a < 2; ++a) _Pragma("unroll") for (int b = 0; b < 2; ++b) _Pragma("unroll") for (int m = 0; m < 4; ++m) _Pragma("unroll") for (int n = 0; n < 2; ++n) acc[a][b][m][n] = (f32x4){0.f, 0.f, 0.f, 0.f}; } } while (0)
    PG8_ACC_INIT(0);
    bf16x8 At[4][2], B0[2][2], B1[2][2];
    const char* cA = cur.A; const char* cB = cur.B;
    PG8_STAGE(PG8_SB(0, 0), cB, voffB); PG8_STAGE(PG8_SB(0, 1), cB + hstep, voffB); PG8_STA(PG8_SA(0, 0), cA, 0, vG); PG8_STA(PG8_SA(0, 1), cA, 1, vG);
    if (wr == 1) PG8_BAR;
    PG8_WAIT_V(2); PG8_BAR;
    PG8_STAGE(PG8_SB(1, 0), cB + kstep, voffB); PG8_STA(PG8_SA(1, 0), cA + kstep, 0, vG); PG8_STAGE(PG8_SB(1, 1), cB + hstep + kstep, voffB);
    PG8_WAIT_V(6); PG8_BAR;
    for (;;) {
        const bool has_next = S.next(ui + 1, nxt);
        const char* nA = has_next ? nxt.A : cA; const char* nB = has_next ? nxt.B : cB;
        if constexpr (NTAB > 0) { if (has_next) PG8_TAB_DMA(nxt, ui + 1); }
#define PG8_TRIP() do { \
            const bool last = (t == nt - 2); \
            const char* a1 = cA + (size_t)(t + 1) * kstep; \
            const char* a2 = last ? nA : cA + (size_t)(t + 2) * kstep; const char* b2 = last ? nB : cB + (size_t)(t + 2) * kstep; \
            const char* a3 = a2 + kstep; const char* b3 = b2 + kstep; \
            unsigned vS[2][2]; \
            if constexpr (GATHER) { if (last && has_next) PG8_IDS_READ(nxt, ui + 1, vGn); \
                _Pragma("unroll") \
                for (int h = 0; h < 2; ++h) \
                _Pragma("unroll") \
                    for (int i = 0; i < 2; ++i) vS[h][i] = (last && has_next) ? vGn[h][i] : vG[h][i]; } \
            PG8_LDB(B0, 0, 0); PG8_LDB(B1, 0, 1); PG8_SCHED; PG8_LDA(At, 0, 0); PG8_STA(PG8_SA(1, 1), a1, 1, vG); \
            PG8_WAIT_V(8); PG8_WAIT_L(0); PG8_BAR; PG8_MMA(0, 0, At, B0); PG8_MMA(0, 1, At, B1); PG8_BAR; PG8_SCHED; \
            PG8_LDA(At, 0, 1); PG8_STAGE(PG8_SB(0, 0), b2, voffB); PG8_STAGE(PG8_SB(0, 1), b2 + hstep, voffB); PG8_STA(PG8_SA(0, 0), a2, 0, vS); \
            PG8_WAIT_V(8); PG8_WAIT_L(0); PG8_BAR; PG8_MMA(1, 0, At, B0); PG8_MMA(1, 1, At, B1); PG8_BAR; PG8_SCHED; \
            PG8_LDB(B0, 1, 0); PG8_LDB(B1, 1, 1); PG8_SCHED; PG8_LDA(At, 1, 0); PG8_STA(PG8_SA(0, 1), a2, 1, vS); \
            PG8_WAIT_V(8); PG8_WAIT_L(0); PG8_BAR; PG8_MMA(0, 0, At, B0); PG8_MMA(0, 1, At, B1); PG8_BAR; PG8_SCHED; \
            PG8_LDA(At, 1, 1); PG8_STAGE(PG8_SB(1, 0), b3, voffB); PG8_STAGE(PG8_SB(1, 1), b3 + hstep, voffB); PG8_STA(PG8_SA(1, 0), a3, 0, vS); \
            PG8_WAIT_V(8); PG8_WAIT_L(0); PG8_BAR; PG8_MMA(1, 0, At, B0); PG8_MMA(1, 1, At, B1); PG8_BAR; PG8_SCHED; \
        } while (0)
        if constexpr (Epi::MIDK) {
            for (int t = 0; t < nt / 2; t += 2) PG8_TRIP();
            PG8_SCHED; E.mid(acc, cur, wr, wc, fr, fq); PG8_SCHED;
            for (int t = nt / 2; t < nt; t += 2) PG8_TRIP();
        } else {
            for (int t = 0; t < nt; t += 2) PG8_TRIP();
        }
#undef PG8_TRIP
        if constexpr (ALIGN_EPI) { if (wr == 0) PG8_BAR; }
        E(acc, cur, wr, wc, fr, fq, tabs + (ui % 3) * 3072);
        if constexpr (Epi::PROBE2X) { E(acc, cur, wr, wc, fr, fq, tabs + (ui % 3) * 3072); }
        if (!has_next) break;
        PG8_ACC_INIT(ui + 1);
        cur = nxt; cA = nA; cB = nB; ++ui;
        if constexpr (GATHER) {
#pragma unroll
            for (int h = 0; h < 2; ++h)
#pragma unroll
                for (int i = 0; i < 2; ++i) vG[h][i] = vGn[h][i]; }
        if constexpr (ALIGN_EPI) { if (wr == 1) PG8_BAR; }
    }
    PG8_WAIT_V(0);
    if constexpr (!ALIGN_EPI) { if (wr == 0) PG8_BAR; }
    PG8_BAR;
#undef PG8_SA
#undef PG8_SB
#undef PG8_STAGE
#undef PG8_STA
#undef PG8_LDA
#undef PG8_LDB
#undef PG8_MMA
#undef PG8_WAIT_V
#undef PG8_WAIT_L
#undef PG8_BAR
#undef PG8_SCHED
#undef PG8_TAB_DMA
#undef PG8_IDS_READ
#undef PG8_ACC_INIT
}
}

constexpr int NWAVES = 8, NTHR = 512;
constexpr int NPH = 13;
constexpr int N_LAUNCHES = MK_N_LAUNCHES;
constexpr int D = 1024, BATCH = 4, SEQ = 8192, M = BATCH * SEQ;
constexpr int DIN = 5128, NPROJ = 5120;
constexpr int C_Q = 0, C_K = 512, C_V = 1024, C_Z = 1536, C_XB = 2048, C_YB = 2560, C_GT = 3072;
constexpr int NE = 32, TOPK = 4, FF = 1024, NASG = M * TOPK;
constexpr int LCH = 128, NLCH = SEQ / LCH;
constexpr float EPS = 1e-6f;
constexpr int NSPLIT = 16;

constexpr size_t MiB = 1u << 20;
constexpr size_t WS_CTL = 0, CTL_ZERO_BYTES = 1 * MiB;
constexpr size_t WS_MOD = 1 * MiB;
constexpr size_t WS_BA = 2 * MiB;
constexpr size_t WS_BG = 3 * MiB;
constexpr size_t WS_LEND = 4 * MiB;
constexpr size_t WS_TOPI = 5 * MiB;
constexpr size_t WS_TOPW = 5 * MiB + 512 * 1024;
constexpr size_t WS_LIST = 6 * MiB;
constexpr size_t WS_WGH = 10 * MiB;
constexpr size_t WS_WGL = 11 * MiB;
constexpr size_t WS_CB = 12 * MiB;
constexpr size_t WS_WIN = 16 * MiB;
constexpr size_t WS_WBG = 26 * MiB, WS_WBL = 27 * MiB;
constexpr size_t WS_WOUT = 28 * MiB;
constexpr size_t WS_W1 = 32 * MiB;
constexpr size_t WS_W2 = 160 * MiB;
constexpr size_t WS_H = 224 * MiB;
constexpr size_t WS_X2 = 288 * MiB;
constexpr size_t WS_HLOC = 288 * MiB, WS_PLOC = 320 * MiB, WS_OCAT = 352 * MiB;
constexpr size_t WS_LISTW = 352 * MiB;
constexpr size_t WS_MERGED = 416 * MiB;
constexpr size_t WS_PROJ = 480 * MiB;
constexpr size_t WS_GBLOB = 800 * MiB;
constexpr size_t WS_GU = 912 * MiB;
constexpr size_t WS_GL = 944 * MiB;
constexpr size_t WS_OGDN = 992 * MiB;
constexpr size_t WS_XS = 480 * MiB;
constexpr size_t WS_ACT = 752 * MiB;
constexpr size_t WS_Y = 480 * MiB;
constexpr size_t WS_END = 1024 * MiB;
constexpr int MAXSLOT = NASG + NE * 256;
constexpr int CW_TMO = 0;
constexpr int CW_CNT = 1024;
constexpr int CW_LRU = 2048;
constexpr int CW_MOE = 2176;
constexpr int CW_GDN2 = 2112;
constexpr int SG0 = 16, SGC = 32, NSTG = 1 + (128 - 16 - SG0 + SGC - 1) / SGC;
__device__ __forceinline__ int gdn_stage_of(int c) { return c < SG0 ? 0 : 1 + (c - SG0) / SGC; }
constexpr int CW_BAR = 4096;
constexpr int RING_BYTES = 155648;
constexpr int LDSCTL_OFF = RING_BYTES, MISC_OFF = LDSCTL_OFF + 320;
constexpr int AUX_OFF = RING_BYTES + 1024;
constexpr int LDS_BYTES = 163840;

#define GAS __attribute__((address_space(1)))
#define LAS __attribute__((address_space(3)))
typedef unsigned short bf16;
typedef unsigned v4u __attribute__((ext_vector_type(4)));
typedef unsigned v2u __attribute__((ext_vector_type(2)));
typedef float f32x4 __attribute__((ext_vector_type(4)));
typedef float f32x2 __attribute__((ext_vector_type(2)));
typedef float f32x16 __attribute__((ext_vector_type(16)));
typedef __bf16 b16x2_t __attribute__((ext_vector_type(2)));
__device__ __forceinline__ unsigned pkbf(float a, float b) { f32x2 v = {a, b}; b16x2_t r = __builtin_convertvector(v, b16x2_t); return __builtin_bit_cast(unsigned, r); }
__device__ __forceinline__ unsigned f2bf(float f) { return pkbf(f, 0.f) & 0xffffu; }
__device__ __forceinline__ unsigned pk2(float lo, float hi) { return pkbf(lo, hi); }
#define RLX_AGENT __ATOMIC_RELAXED, __HIP_MEMORY_SCOPE_AGENT
#define LDS_WAIT() asm volatile("s_waitcnt lgkmcnt(0)" ::: "memory")
#define LBAR() do { asm volatile("s_waitcnt lgkmcnt(0)" ::: "memory"); __builtin_amdgcn_s_barrier(); asm volatile("" ::: "memory"); } while (0)
__device__ __forceinline__ float bflo(unsigned w) { return __builtin_bit_cast(float, w << 16); }
__device__ __forceinline__ float bfhi(unsigned w) { return __builtin_bit_cast(float, w & 0xffff0000u); }
__device__ __forceinline__ float bf1(bf16 h) { return __builtin_bit_cast(float, (unsigned)h << 16); }
__device__ __forceinline__ float sigmoidf_(float v) { return __builtin_amdgcn_rcpf(1.f + __expf(-v)); }
__device__ __forceinline__ float siluf_(float v) { return v * __builtin_amdgcn_rcpf(1.f + __expf(-v)); }
__device__ __forceinline__ float gelu_tanh_(float x) { const float u2 = 1.5957691216057308f * (x + 0.044715f * x * x * x); return x * __builtin_amdgcn_rcpf(1.f + __expf(-u2)); }
__device__ __forceinline__ float softplusf_(float v) { return v > 20.f ? v : log1pf(__expf(v)); }
__device__ __forceinline__ float wave_sum(float v) {
#pragma unroll
    for (int o = 1; o < 64; o <<= 1) v += __shfl_xor(v, o);
    return v;
}
__device__ __forceinline__ float wave_max(float v) {
#pragma unroll
    for (int o = 1; o < 64; o <<= 1) v = fmaxf(v, __shfl_xor(v, o));
    return v;
}
__device__ __forceinline__ int wave_min_i(int v) {
#pragma unroll
    for (int o = 1; o < 64; o <<= 1) { int w = __shfl_xor(v, o); v = w < v ? w : v; }
    return v;
}

#define XB_TMO      128
#define XB_XCNT(j)  (256  + 64 * (j))
#define XB_XSUB(j)  (1280 + 64 * (j))
#define XB_XGEN(j)  (2304 + 64 * (j))
#define XB_TOP      3328
#define XB_TOPGEN   3392
#define XCD_BAR_WORDS 3456
#define XB_SPIN_CAP (1u << 22)
__device__ __forceinline__ unsigned xb_ld(unsigned* p)              { return __hip_atomic_load(p, __ATOMIC_RELAXED, __HIP_MEMORY_SCOPE_AGENT); }
__device__ __forceinline__ unsigned xb_add(unsigned* p, unsigned v) { return __hip_atomic_fetch_add(p, v, __ATOMIC_RELAXED, __HIP_MEMORY_SCOPE_AGENT); }
__device__ __forceinline__ unsigned xb_xcc_id() { return (unsigned)__builtin_amdgcn_s_getreg((3 << 11) | 20) & 0xFu; }
#define XB_SPIN(cond, bar) do { unsigned _sp = 0; while (cond) { __builtin_amdgcn_s_sleep(1); \
    if ((++_sp & 255u) == 0u) { if (xb_ld(&(bar)[XB_TMO])) break; if (_sp > XB_SPIN_CAP) { atomicAdd(&(bar)[XB_TMO], 1u); break; } } } } while (0)
struct XcdBarrier { unsigned* bar; unsigned x; volatile LAS unsigned* st; };
__device__ __forceinline__ XcdBarrier xcd_barrier_post(unsigned* bar, volatile LAS unsigned* st) {
    XcdBarrier b; b.bar = bar; b.x = xb_xcc_id(); b.st = st;
    if (threadIdx.x == 0) (void)xb_add(&bar[XB_XCNT(b.x)], 1u);
    return b;
}
__device__ __forceinline__ void xcd_barrier_complete(unsigned* bar, unsigned x, unsigned& nloc, unsigned& nx) {
    const unsigned G = gridDim.x * gridDim.y * gridDim.z;
    unsigned sum, cnt, mine, sp = 0u;
    for (;;) {
        sum = 0u; cnt = 0u; mine = 0u;
#pragma unroll
        for (unsigned j = 0; j < 16; ++j) { const unsigned c = xb_ld(&bar[XB_XCNT(j)]); sum += c; cnt += (c > 0u) ? 1u : 0u; mine = (j == x) ? c : mine; }
        if (sum == G) break;
        __builtin_amdgcn_s_sleep(1);
        if ((++sp & 255u) == 0u) { if (xb_ld(&bar[XB_TMO])) break; if (sp > XB_SPIN_CAP) { atomicAdd(&bar[XB_TMO], 1u); break; } }
    }
    nloc = mine > 0u ? mine : 1u; nx = cnt > 0u ? cnt : 1u;
}
__device__ __forceinline__ void xcd_barrier(const XcdBarrier& b) {
    asm volatile("s_waitcnt vmcnt(0)" ::: "memory");
    __syncthreads();
    if (threadIdx.x == 0) {
        unsigned* bar = b.bar;
        __builtin_amdgcn_s_waitcnt(0);
        unsigned nloc = b.st[0], nx = b.st[1];
        if (nloc == 0u) { xcd_barrier_complete(bar, b.x, nloc, nx); b.st[0] = nloc; b.st[1] = nx; }
        const unsigned old = xb_add(&bar[XB_XSUB(b.x)], 1u);
        const unsigned gen = old / nloc;
        if (old + 1u == (gen + 1u) * nloc) {
            __builtin_amdgcn_fence(__ATOMIC_RELEASE, "agent");
            asm volatile("s_waitcnt vmcnt(0)" ::: "memory");
            const unsigned og = xb_add(&bar[XB_TOP], 1u);
            const unsigned tg = og / nx;
            if (og + 1u == (tg + 1u) * nx) xb_add(&bar[XB_TOPGEN], 1u);
            else XB_SPIN(xb_ld(&bar[XB_TOPGEN]) == tg, bar);
            __builtin_amdgcn_fence(__ATOMIC_ACQUIRE, "agent");
            xb_add(&bar[XB_XGEN(b.x)], 1u);
            asm volatile("s_waitcnt vmcnt(0)" ::: "memory");
        } else {
            XB_SPIN(xb_ld(&bar[XB_XGEN(b.x)]) == gen, bar);
            __builtin_amdgcn_fence(__ATOMIC_ACQUIRE, "agent");
            asm volatile("s_waitcnt vmcnt(0)" ::: "memory");
        }
    }
    __syncthreads();
}

struct Args { const float* in[28]; float* out; unsigned char* ws; int ph_lo, ph_hi, li, pad; };
enum { I_X = 0, I_C, I_WADA, I_BADA, I_NMIX, I_NFFN, I_WIN, I_GCONV, I_GALOG, I_GDT, I_GNORM, I_LCONVW, I_LCONVB, I_LWA, I_LBA, I_LWX, I_LBX, I_LLAM,
       I_WBG, I_WBL, I_WOUT, I_WR, I_BR, I_W1, I_B1, I_W2, I_B2, I_NFIN };

struct TrItem { const float* W; bf16* WT; int ld, K, k0, n0; };
__device__ __forceinline__ void p0_tr_load(const TrItem& t, float (&v)[32], int lane) {
#pragma unroll
    for (int i = 0; i < 32; ++i) { const int kk = 2 * i + (lane >> 5); v[i] = t.W[(size_t)(t.k0 + kk) * t.ld + t.n0 + (lane & 31)]; }
}
__device__ __forceinline__ void p0_tr_finish(const TrItem& t, const float (&v)[32], float* scr, int lane) {
#pragma unroll
    for (int i = 0; i < 32; ++i) { const int kk = 2 * i + (lane >> 5); scr[kk * 33 + (lane & 31)] = v[i]; }
    LDS_WAIT(); asm volatile("" ::: "memory");
    const int c = lane & 7;
#pragma unroll
    for (int j = 0; j < 4; ++j) { const int n = (lane >> 3) + 8 * j; const float* s = scr + (8 * c) * 33 + n;
        v4u o; o.x = pkbf(s[0 * 33], s[1 * 33]); o.y = pkbf(s[2 * 33], s[3 * 33]); o.z = pkbf(s[4 * 33], s[5 * 33]); o.w = pkbf(s[6 * 33], s[7 * 33]);
        *(v4u*)(t.WT + (size_t)(t.n0 + n) * t.K + t.k0 + 8 * c) = o; }
    LDS_WAIT(); asm volatile("" ::: "memory");
}
__device__ __forceinline__ void p0_transpose_item(const float* W, int ld, int K, int nblk, bf16* WT, float* scr, int item, int lane) {
    TrItem t{W, WT, ld, K, 64 * (item / nblk), 32 * (item % nblk)}; float v[32]; p0_tr_load(t, v, lane); p0_tr_finish(t, v, scr, lane);
}

typedef short s16x4_t __attribute__((ext_vector_type(4)));
__device__ __forceinline__ void tr64_load(const TrItem& t, f32x4 (&v)[16], int lane) {
    const float* p = t.W + (size_t)(t.k0 + (lane >> 4)) * t.ld + t.n0 + 4 * (lane & 15);
#pragma unroll
    for (int i = 0; i < 16; ++i) v[i] = *(const f32x4*)(p + (size_t)(4 * i) * t.ld);
}
__device__ __forceinline__ void tr64_finish(const TrItem& t, const f32x4 (&v)[16], LAS unsigned char* T, int lane) {
    {
        const int q = lane >> 4, g4 = lane & 15;
#pragma unroll
        for (int i = 0; i < 16; ++i) *(LAS f32x4*)(T + (4 * i + q) * 256 + ((g4 ^ (i & 14)) << 4)) = v[i];
    }
    LDS_WAIT(); asm volatile("" ::: "memory");
    const int r = lane >> 3, c = lane & 7;
    bf16* op = t.WT + (size_t)(t.n0 + r) * t.K + t.k0 + 8 * c;
#pragma unroll
    for (int j2 = 0; j2 < 8; ++j2) {
        const int n = 8 * j2 + r;
        LAS const float* rp = (LAS const float*)(T + (8 * c) * 256 + ((((n >> 2) ^ (2 * c)) & 15) << 4) + ((n & 3) << 2));
        float f[8];
#pragma unroll
        for (int j = 0; j < 8; ++j) f[j] = rp[j * 64];
        *(v4u*)(op + (size_t)(8 * j2) * t.K) = (v4u){pkbf(f[0], f[1]), pkbf(f[2], f[3]), pkbf(f[4], f[5]), pkbf(f[6], f[7])};
    }
    LDS_WAIT(); asm volatile("" ::: "memory");
}

struct SchedDense {
    const char* A; const char* B; int nM, nN, G, c, K;
    __device__ __forceinline__ bool next(int i, pg8::Unit& u) const {
        if (!pg8::tile_map((long)i * G + c, nM, nN, u.pm, u.pn)) return false;
        u.aux = 0; u.nvalid = 256; u.tp[0] = u.tp[1] = u.tp[2] = nullptr; u.A = pg8::uptr(A + (size_t)u.pm * 256 * K * 2); u.B = pg8::uptr(B + (size_t)u.pn * 256 * K * 2); return true;
    }
};
struct SchedBranch {
    const char *A0, *A1, *B0, *B1; int nM, nN, G, c;
    __device__ __forceinline__ bool next(int i, pg8::Unit& u) const {
        if (!pg8::tile_map((long)(i >> 1) * G + c, nM, nN, u.pm, u.pn)) return false;
        const int g = i & 1; u.aux = g; u.nvalid = 256; u.tp[0] = u.tp[1] = u.tp[2] = nullptr;
        u.A = pg8::uptr((g ? A1 : A0) + (size_t)u.pm * 256 * 512 * 2); u.B = pg8::uptr((g ? B1 : B0) + (size_t)u.pn * 256 * 512 * 2); return true;
    }
};
struct SchedMoe {
    const char* A; const char* W; const int* ts; const int* list; const float* listw; const float* bias; int bias_ld; int T, nN, G, c; size_t wexp; bool gatherA;
    long L0, Lend; bool rot; const unsigned* dep_ctr; unsigned dep_want; long dep_L; int dep_nN;
    __device__ __forceinline__ static long lin_of(int pm, int pn, int nM, int nN) {
        const int nwg = nM * nN, nig = pg8::WGM * nN, gid = pm / pg8::WGM, fm = gid * pg8::WGM, gsz = (nM - fm) < pg8::WGM ? (nM - fm) : pg8::WGM;
        const int wg = gid * nig + pn * gsz + (pm - fm); const int q = nwg / pg8::NXCD, r = nwg % pg8::NXCD;
        int xcd, off; if (wg < r * (q + 1)) { xcd = wg / (q + 1); off = wg - xcd * (q + 1); } else { const int w2 = wg - r * (q + 1); xcd = r + w2 / q; off = w2 - (xcd - r) * q; }
        return (long)off * pg8::NXCD + xcd;
    }
    __device__ __forceinline__ bool next(int i, pg8::Unit& u) const {
        int r = i;
        if (rot) { const long span = Lend - L0 - c; const int R = span > 0 ? (int)((span + G - 1) / G) : 0; if (i >= R) return false; r = (i + 1 < R) ? i + 1 : 0; }
        const long L = L0 + (long)r * G + c;
        if (L >= Lend || !pg8::tile_map(L, T, nN, u.pm, u.pn)) return false;
        int e = 0;
        for (int j = 1; j < NE; ++j) e += (ts[j] <= u.pm) ? 1 : 0;
        e = __builtin_amdgcn_readfirstlane(e);
        const int p0 = (u.pm - ts[e]) * 256, rem = ts[40 + e] - p0;
        u.aux = e; u.nvalid = __builtin_amdgcn_readfirstlane(rem < 256 ? rem : 256);
        u.tp[0] = (const void*)pg8::uptr((const char*)(list + (size_t)e * M + p0)); u.tp[1] = (const void*)pg8::uptr((const char*)(bias + (size_t)e * bias_ld + u.pn * 256)); u.tp[2] = (const void*)pg8::uptr((const char*)(listw + (size_t)e * M + p0));
        u.A = gatherA ? pg8::uptr(A) : pg8::uptr(A + (size_t)u.pm * 256 * 1024 * 2); u.B = pg8::uptr(W + (size_t)e * wexp + (size_t)u.pn * 256 * 1024 * 2);
        if (dep_ctr) {
            bool dep = false;
            for (int pn1 = 0; pn1 < dep_nN; ++pn1) dep = dep || (lin_of(u.pm, pn1, T, dep_nN) >= dep_L);
            if (__builtin_amdgcn_readfirstlane(dep ? 1 : 0)) { unsigned sp = 0;
                while (__hip_atomic_load(dep_ctr, __ATOMIC_RELAXED, __HIP_MEMORY_SCOPE_AGENT) < dep_want) { __builtin_amdgcn_s_sleep(2); if (++sp > (1u << 22)) break; }
                __builtin_amdgcn_fence(__ATOMIC_ACQUIRE, "agent"); }
        }
        return true;
    }
};

struct EpiProj { static constexpr bool BIAS_INIT = false; static constexpr bool MIDK = false; static constexpr bool PROBE2X = (PROBE_EPI & 1) != 0;
    static constexpr bool PERM = true;
    bf16* O;
    __device__ __forceinline__ void operator()(const pg8::f32x4 (&acc)[2][2][4][2], const pg8::Unit& u, int wr, int wc, int fr, int fq, const PG8_LAS unsigned char* tab) const {
        const int row0 = u.pm * 256 + wr * 64 + fr, col0 = u.pn * 256 + wc * 32 + 8 * fq; const bool sig = u.pn >= 12;
#pragma unroll
        for (int ai = 0; ai < 2; ++ai)
#pragma unroll
            for (int m = 0; m < 4; ++m) { bf16* rowp = O + (size_t)(row0 + ai * 128 + m * 16) * NPROJ + col0;
                pg8::f32x4 g0 = acc[ai][0][m][0], g1 = acc[ai][0][m][1], l0 = acc[ai][1][m][0], l1 = acc[ai][1][m][1];
                if (sig) {
#pragma unroll
                    for (int j = 0; j < 4; ++j) {
                        const float eg0 = __expf(-g0[j]), el0 = __expf(-l0[j]), eg1 = __expf(-g1[j]), el1 = __expf(-l1[j]);
                        g0[j] = fminf(1.f + el0, 1e6f) * __builtin_amdgcn_rcpf(1.f + eg0); l0[j] = fmaxf(__builtin_amdgcn_rcpf(1.f + el0), 1e-6f);
                        g1[j] = fminf(1.f + el1, 1e6f) * __builtin_amdgcn_rcpf(1.f + eg1); l1[j] = fmaxf(__builtin_amdgcn_rcpf(1.f + el1), 1e-6f); } }
                { v4u w; w.x = pg8::cvt_pk_bf16(g0[0], g0[1]); w.y = pg8::cvt_pk_bf16(g0[2], g0[3]); w.z = pg8::cvt_pk_bf16(g1[0], g1[1]); w.w = pg8::cvt_pk_bf16(g1[2], g1[3]); *(v4u*)(rowp) = w; }
                { v4u w; w.x = pg8::cvt_pk_bf16(l0[0], l0[1]); w.y = pg8::cvt_pk_bf16(l0[2], l0[3]); w.z = pg8::cvt_pk_bf16(l1[0], l1[1]); w.w = pg8::cvt_pk_bf16(l1[2], l1[3]); *(v4u*)(rowp + 128) = w; } }
    }
};
struct EpiBranch { static constexpr bool BIAS_INIT = false; static constexpr bool MIDK = true; static constexpr bool PROBE2X = false;
    static constexpr bool PERM = true;
    bf16* O; const bf16* proj;
    __device__ __forceinline__ void mid(pg8::f32x4 (&acc)[2][2][4][2], const pg8::Unit& u, int wr, int wc, int fr, int fq) const {
        int row0 = u.pm * 256 + wr * 64 + fr; const int ci = wc * 32 + 8 * fq;
        asm volatile("" : "+v"(row0));
#pragma unroll
        for (int ai = 0; ai < 2; ++ai) {
            v4u R[4][2];
#pragma unroll
            for (int m = 0; m < 4; ++m) { const bf16* gp = proj + (size_t)(row0 + ai * 128 + m * 16) * NPROJ + C_GT + 512 * u.pn + ci;
#pragma unroll
                for (int bj = 0; bj < 2; ++bj) R[m][bj] = *(const v4u*)(gp + bj * 256); }
            __builtin_amdgcn_sched_barrier(0);
#pragma unroll
            for (int m = 0; m < 4; ++m)
#pragma unroll
                for (int bj = 0; bj < 2; ++bj) { const v4u g = R[m][bj];
                    acc[ai][bj][m][0] = acc[ai][bj][m][0] * (pg8::f32x4){bflo(g.x), bfhi(g.x), bflo(g.y), bfhi(g.y)}; acc[ai][bj][m][1] = acc[ai][bj][m][1] * (pg8::f32x4){bflo(g.z), bfhi(g.z), bflo(g.w), bfhi(g.w)}; }
            __builtin_amdgcn_sched_barrier(0);
        }
    }
    __device__ __forceinline__ void operator()(const pg8::f32x4 (&acc)[2][2][4][2], const pg8::Unit& u, int wr, int wc, int fr, int fq, const PG8_LAS unsigned char* tab) const {
        const int row0 = u.pm * 256 + wr * 64 + fr, col0 = u.pn * 256 + wc * 32 + 8 * fq;
        v4u Lq[2][4][2];
#pragma unroll
        for (int ai = 0; ai < 2; ++ai)
#pragma unroll
            for (int m = 0; m < 4; ++m) { const bf16* gp = proj + (size_t)(row0 + ai * 128 + m * 16) * NPROJ + C_GT + 512 * u.pn + 128 + wc * 32 + 8 * fq;
#pragma unroll
                for (int bj = 0; bj < 2; ++bj) Lq[ai][m][bj] = *(const v4u*)(gp + bj * 256); }
        __builtin_amdgcn_sched_barrier(0);
#pragma unroll
        for (int ai = 0; ai < 2; ++ai)
#pragma unroll
            for (int m = 0; m < 4; ++m) { const size_t r = (size_t)(row0 + ai * 128 + m * 16); bf16* rowp = O + r * D + col0;
#pragma unroll
                for (int bj = 0; bj < 2; ++bj) { const v4u l = Lq[ai][m][bj];
                    const pg8::f32x4 v0 = acc[ai][bj][m][0], v1 = acc[ai][bj][m][1];
                    const float o[8] = {v0[0] * bflo(l.x), v0[1] * bfhi(l.x), v0[2] * bflo(l.y), v0[3] * bfhi(l.y), v1[0] * bflo(l.z), v1[1] * bfhi(l.z), v1[2] * bflo(l.w), v1[3] * bfhi(l.w)};
                    v4u w; w.x = pg8::cvt_pk_bf16(o[0], o[1]); w.y = pg8::cvt_pk_bf16(o[2], o[3]); w.z = pg8::cvt_pk_bf16(o[4], o[5]); w.w = pg8::cvt_pk_bf16(o[6], o[7]);
                    *(v4u*)(rowp + bj * 128) = w; } }
    }
};
struct EpiOut { static constexpr bool BIAS_INIT = false; static constexpr bool MIDK = false; static constexpr bool PROBE2X = (PROBE_EPI & 4) != 0;
    static constexpr bool PERM = true;
    bf16* X2; const float* x; const float* mod;
    __device__ __forceinline__ void operator()(const pg8::f32x4 (&acc)[2][2][4][2], const pg8::Unit& u, int wr, int wc, int fr, int fq, const PG8_LAS unsigned char* tab) const {
        const int row0 = u.pm * 256 + wr * 64 + fr, col0 = u.pn * 256 + wc * 32 + 8 * fq; const int b = u.pm >> 5;
        pg8::f32x4 gm[2][2];
#pragma unroll
        for (int bj = 0; bj < 2; ++bj)
#pragma unroll
            for (int n = 0; n < 2; ++n) gm[bj][n] = *(const pg8::f32x4*)(mod + b * 6144 + 2048 + col0 + bj * 128 + n * 4);
#pragma unroll
        for (int ai = 0; ai < 2; ++ai) {
            pg8::f32x4 X[4][2][2];
#pragma unroll
            for (int m = 0; m < 4; ++m) { const size_t off = (size_t)(row0 + ai * 128 + m * 16) * D + col0;
#pragma unroll
                for (int bj = 0; bj < 2; ++bj) { X[m][bj][0] = *(const pg8::f32x4*)(x + off + bj * 128); X[m][bj][1] = *(const pg8::f32x4*)(x + off + bj * 128 + 4); } }
            __builtin_amdgcn_sched_barrier(0);
#pragma unroll
            for (int m = 0; m < 4; ++m) { const size_t off = (size_t)(row0 + ai * 128 + m * 16) * D + col0;
#pragma unroll
                for (int bj = 0; bj < 2; ++bj) {
                    const pg8::f32x4 v0 = X[m][bj][0] + gm[bj][0] * acc[ai][bj][m][0], v1 = X[m][bj][1] + gm[bj][1] * acc[ai][bj][m][1];
                    v4u w; w.x = pg8::cvt_pk_bf16(v0[0], v0[1]); w.y = pg8::cvt_pk_bf16(v0[2], v0[3]); w.z = pg8::cvt_pk_bf16(v1[0], v1[1]); w.w = pg8::cvt_pk_bf16(v1[2], v1[3]);
                    *(v4u*)(X2 + off + bj * 128) = w; } }
            __builtin_amdgcn_sched_barrier(0);
        }
    }
};
struct EpiMoe1 { static constexpr bool BIAS_INIT = true; static constexpr bool MIDK = false; static constexpr bool PROBE2X = (PROBE_EPI & 8) != 0;
    static constexpr bool PERM = true;
    bf16* ACT;
    __device__ __forceinline__ void operator()(const pg8::f32x4 (&acc)[2][2][4][2], const pg8::Unit& u, int wr, int wc, int fr, int fq, const PG8_LAS unsigned char* tab) const {
        const int row0 = u.pm * 256 + wr * 64 + fr, col0 = u.pn * 256 + wc * 32 + 8 * fq;
#pragma unroll
        for (int ai = 0; ai < 2; ++ai)
#pragma unroll
            for (int m = 0; m < 4; ++m) { bf16* rowp = ACT + (size_t)(row0 + ai * 128 + m * 16) * FF + (col0 >> 1);
#pragma unroll
                for (int bj = 0; bj < 2; ++bj) { const pg8::f32x4 v0 = acc[ai][bj][m][0], v1 = acc[ai][bj][m][1];
                    typedef float f2 __attribute__((ext_vector_type(2)));
                    f2 g0 = {v0[0], v0[2]}, g1 = {v1[0], v1[2]}, l0 = {v0[1], v0[3]}, l1 = {v1[1], v1[3]};
                    g0 = __builtin_elementwise_min(g0, (f2){7.f, 7.f}); g1 = __builtin_elementwise_min(g1, (f2){7.f, 7.f});
                    l0 = __builtin_elementwise_min(__builtin_elementwise_max(l0, (f2){-7.f, -7.f}), (f2){7.f, 7.f}) + 1.f; l1 = __builtin_elementwise_min(__builtin_elementwise_max(l1, (f2){-7.f, -7.f}), (f2){7.f, 7.f}) + 1.f;
                    const f2 t0 = g0 * (-1.702f * 1.4426950408889634f), t1 = g1 * (-1.702f * 1.4426950408889634f);
                    f2 d0, d1; d0.x = __builtin_amdgcn_exp2f(t0.x); d0.y = __builtin_amdgcn_exp2f(t0.y); d1.x = __builtin_amdgcn_exp2f(t1.x); d1.y = __builtin_amdgcn_exp2f(t1.y);
                    d0 = d0 + 1.f; d1 = d1 + 1.f;
                    f2 r0, r1; r0.x = __builtin_amdgcn_rcpf(d0.x); r0.y = __builtin_amdgcn_rcpf(d0.y); r1.x = __builtin_amdgcn_rcpf(d1.x); r1.y = __builtin_amdgcn_rcpf(d1.y);
                    const f2 a0 = (g0 * r0) * l0, a1 = (g1 * r1) * l1;
                    const float a[4] = {a0.x, a0.y, a1.x, a1.y};
                    v2u w; w.x = pg8::cvt_pk_bf16(a[0], a[1]); w.y = pg8::cvt_pk_bf16(a[2], a[3]);
                    *(v2u*)(rowp + bj * 64) = w; } }
    }
};
struct EpiMoe2 { static constexpr bool BIAS_INIT = true; static constexpr bool MIDK = false; static constexpr bool PROBE2X = (PROBE_EPI & 16) != 0;
    static constexpr bool PERM = true;
    bf16* Y;
    __device__ __forceinline__ void operator()(const pg8::f32x4 (&acc)[2][2][4][2], const pg8::Unit& u, int wr, int wc, int fr, int fq, const PG8_LAS unsigned char* tab) const {
        const int rl0 = wr * 64 + fr, col0 = u.pn * 256 + wc * 32 + 8 * fq;
        const PG8_LAS int* idp = (const PG8_LAS int*)tab; const PG8_LAS float* gwp = (const PG8_LAS float*)(tab + 2048);
#pragma unroll
        for (int ai = 0; ai < 2; ++ai)
#pragma unroll
            for (int m = 0; m < 4; ++m) { const int rl = rl0 + ai * 128 + m * 16;
                if (rl < u.nvalid) { const int a = idp[rl]; const float gw = gwp[rl]; bf16* rowp = Y + (size_t)a * D + col0;
#pragma unroll
                    for (int bj = 0; bj < 2; ++bj) { const pg8::f32x4 v0 = acc[ai][bj][m][0] * gw, v1 = acc[ai][bj][m][1] * gw;
                        v4u w; w.x = pg8::cvt_pk_bf16(v0[0], v0[1]); w.y = pg8::cvt_pk_bf16(v0[2], v0[3]); w.z = pg8::cvt_pk_bf16(v1[0], v1[1]); w.w = pg8::cvt_pk_bf16(v1[2], v1[3]);
                        *(v4u*)(rowp + bj * 128) = w; } } }
    }
};

__device__ __forceinline__ void moe_tile_table(const unsigned* cnt, int* ts, int tid) {
    if (tid == 0) { int acc = 0; for (int e = 0; e < NE; ++e) { ts[e] = acc; acc += (int)((cnt[e] + 255u) >> 8); ts[40 + e] = (int)cnt[e]; } ts[NE] = acc; }
    __syncthreads();
}

template <int I> struct SolveRow {
    static __device__ __forceinline__ void run(float (&X)[64], const LAS float* AM, const LAS float* GT, const LAS bf16* src, float sel, const f32x4 (&cur)[16], float ycur) {
        f32x4 nxt[16]; float ynxt = 0.f;
        if constexpr (I + 1 < 64) {
#pragma unroll
            for (int j4 = 0; j4 < (I + 4) / 4; ++j4) nxt[j4] = *(const LAS f32x4*)(AM + (I + 1) * 64 + 4 * j4);
            const float eg_ = GT[128 + I + 1]; ynxt = GT[I + 1] * bf1(src[(I + 1) * 136]) * (sel + (1.f - sel) * eg_);
        }
        __builtin_amdgcn_sched_barrier(0);
        float acc = ycur, acc2 = 0.f;
#pragma unroll
        for (int j4 = 0; j4 < (I + 3) / 4; ++j4) { const f32x4 a4 = cur[j4];
            if (4 * j4 + 0 < I) acc -= a4[0] * X[4 * j4 + 0]; if (4 * j4 + 1 < I) acc2 -= a4[1] * X[4 * j4 + 1];
            if (4 * j4 + 2 < I) acc -= a4[2] * X[4 * j4 + 2]; if (4 * j4 + 3 < I) acc2 -= a4[3] * X[4 * j4 + 3]; }
        X[I] = acc + acc2;
        __builtin_amdgcn_sched_barrier(0);
        if constexpr (I + 1 < 64) SolveRow<I + 1>::run(X, AM, GT, src, sel, nxt, ynxt);
    }
};

#define GDN_ITEM(k_, bh_, n_) do { if (mode == 0) { bh_ = blk >> 4; n_ = (blk & 15) + 16 * (k_); } else { const int q__ = blk + nb * (k_); bh_ = q__ & 15; n_ = NSPLIT + (q__ >> 4); } } while (0)
__device__ __forceinline__ void gdn_prep_items(unsigned char* lds, unsigned char* ws, const bf16* PROJ, const float* BA, const float* gconv, const float* galog, const float* gdt, const int mode, const int blk, const int nb, const int cnt, unsigned* gctl = nullptr) {
        {
            int tid = threadIdx.x; asm volatile("" : "+v"(tid)); int lane = tid & 63, wave = __builtin_amdgcn_readfirstlane(tid >> 6);
            unsigned char* L = lds;
            bf16* QB = (bf16*)(L + 0); bf16* KB = (bf16*)(L + 17408); bf16* VB = (bf16*)(L + 34816);
            float* AM = (float*)(L + 52224);
            unsigned char* QKS = L + 68608;
            unsigned char* WNS = L + 76800;
            float* CW = (float*)(L + 93184);
            float* GT = (float*)(L + 99328);
            unsigned char* GBLOB = ws + WS_GBLOB; unsigned char* GU = ws + WS_GU; float* GLv = (float*)(ws + WS_GL);
            unsigned char* RAWG = L + 100352;
            int hcur = -1;
#define GDN_DMA(b_, h_, n_) do { const size_t mm_ = (size_t)(b_) * SEQ + (n_) * 64; \
                for (int k_ = wave; k_ < 51; k_ += NWAVES) { int q_ = k_ * 64 + lane; q_ = q_ < 3216 ? q_ : 3215; const int p_ = q_ >> 4, c16_ = q_ & 15, row_ = p_ / 3, X_ = p_ - row_ * 3; \
                    long mr_ = (long)mm_ - 3 + row_; if ((n_) == 0 && row_ < 3) mr_ = (long)mm_; \
                    __builtin_amdgcn_global_load_lds((const unsigned*)(PROJ + (size_t)mr_ * NPROJ + X_ * 512 + (h_) * 128 + c16_ * 8), (LAS unsigned*)((LAS unsigned char*)RAWG + k_ * 1024), 16, 0, 0); } } while (0)
            if (cnt > 0) {
            int bh0, n0_; GDN_ITEM(0, bh0, n0_);
            GDN_DMA(bh0 >> 2, bh0 & 3, n0_);
            float blq = 0.f, alq = 0.f;
            if (wave == 0) { const size_t mq = (size_t)(bh0 >> 2) * SEQ + n0_ * 64 + lane; blq = BA[mq * 8 + (bh0 & 3)]; alq = BA[mq * 8 + 4 + (bh0 & 3)]; }
            asm volatile("s_waitcnt vmcnt(0)" ::: "memory");
            for (int ii = 0; ii < cnt; ++ii) {
                int tid_l = threadIdx.x; asm volatile("" : "+v"(tid_l));
                const int tid = tid_l, lane = tid & 63, wave = __builtin_amdgcn_readfirstlane(tid >> 6);
                int bh, n; GDN_ITEM(ii, bh, n); const int b = bh >> 2, h = bh & 3, it = bh * 128 + n;
                int bh2 = bh, n2 = n; if (ii + 1 < cnt) GDN_ITEM(ii + 1, bh2, n2);
                if (h != hcur) { hcur = h; for (int i = tid; i < 1536; i += NTHR) { const int X = i >> 9, r = i & 511, j = r >> 7, d = r & 127; CW[i] = gconv[j * 1536 + X * 512 + h * 128 + d]; } }
                const size_t m0 = (size_t)b * SEQ + n * 64;
                unsigned char* blob = GBLOB + (size_t)it * 57344;
                LBAR();
                if (mode == 1 && ii > 0) {
                    const int sp_ = gdn_stage_of((blk + nb * (ii - 1)) >> 4), sc_ = gdn_stage_of(n - NSPLIT);
                    if (sp_ != sc_) { asm volatile("s_waitcnt vmcnt(0)" ::: "memory"); LBAR();
                        if (tid == 0) { __builtin_amdgcn_fence(__ATOMIC_RELEASE, "agent"); asm volatile("s_waitcnt vmcnt(0)" ::: "memory"); for (int s_ = sp_; s_ < sc_; ++s_) __hip_atomic_fetch_add(gctl + CW_GDN2 + s_, 1u, RLX_AGENT); } }
                }
                for (int rc_ = 0; rc_ < ((PROBE_SUB & 64) ? 2 : 1); ++rc_)
                {
                    const int tok = tid >> 3, d0 = (tid & 7) * 16;
#pragma unroll
                    for (int X = 0; X < 3; ++X) {
                        float y[16];
#pragma unroll
                        for (int i = 0; i < 16; ++i) y[i] = 0.f;
#pragma unroll
                        for (int j = 0; j < 4; ++j) {
                            if (n * 64 + tok - 3 + j >= 0) {
                                const unsigned char* src = RAWG + (((tok + j) * 3 + X) * 16 + (d0 >> 3)) * 16;
                                const v4u r0 = *(const v4u*)src, r1 = *(const v4u*)(src + 16);
                                const float* cw = CW + (X * 4 + j) * 128 + d0;
                                y[0] += cw[0] * bflo(r0.x); y[1] += cw[1] * bfhi(r0.x); y[2] += cw[2] * bflo(r0.y); y[3] += cw[3] * bfhi(r0.y);
                                y[4] += cw[4] * bflo(r0.z); y[5] += cw[5] * bfhi(r0.z); y[6] += cw[6] * bflo(r0.w); y[7] += cw[7] * bfhi(r0.w);
                                y[8] += cw[8] * bflo(r1.x); y[9] += cw[9] * bfhi(r1.x); y[10] += cw[10] * bflo(r1.y); y[11] += cw[11] * bfhi(r1.y);
                                y[12] += cw[12] * bflo(r1.z); y[13] += cw[13] * bfhi(r1.z); y[14] += cw[14] * bflo(r1.w); y[15] += cw[15] * bfhi(r1.w);
                            }
                        }
                        float ss = 0.f;
#pragma unroll
                        for (int i = 0; i < 16; ++i) { y[i] = siluf_(y[i]); ss += y[i] * y[i]; }
                        if (X < 2) { ss += __shfl_xor(ss, 1); ss += __shfl_xor(ss, 2); ss += __shfl_xor(ss, 4);
                            const float sc = rsqrtf(ss + EPS) * (X == 0 ? 0.08838834764831845f : 1.f);
#pragma unroll
                            for (int i = 0; i < 16; ++i) y[i] *= sc; }
                        bf16* dst = (X == 0 ? QB : X == 1 ? KB : VB) + tok * 136 + d0;
                        v4u o0, o1; o0.x = pkbf(y[0], y[1]); o0.y = pkbf(y[2], y[3]); o0.z = pkbf(y[4], y[5]); o0.w = pkbf(y[6], y[7]);
                        o1.x = pkbf(y[8], y[9]); o1.y = pkbf(y[10], y[11]); o1.z = pkbf(y[12], y[13]); o1.w = pkbf(y[14], y[15]);
                        *(v4u*)dst = o0; *(v4u*)(dst + 8) = o1;
                    }
                }
                if (wave == 0) {
                    const float bl = blq, al = alq;
                    if (ii + 1 < cnt) { const size_t mq = (size_t)(bh2 >> 2) * SEQ + n2 * 64 + lane; blq = BA[mq * 8 + (bh2 & 3)]; alq = BA[mq * 8 + 4 + (bh2 & 3)]; }
                    const float beta = sigmoidf_(bl); const float g = -__expf(galog[h]) * softplusf_(al + gdt[h]);
                    float gc = g;
#pragma unroll
                    for (int o = 1; o < 64; o <<= 1) { const float t = __shfl_up(gc, o); if (lane >= o) gc += t; }
                    const float gl = __shfl(gc, 63);
                    GT[lane] = beta; GT[64 + lane] = gc; GT[128 + lane] = __expf(gc); GT[192 + lane] = __expf(gl - gc);
                    if (lane == 0) { GLv[it] = __expf(gl); *(float*)(QKS + 2048) = __expf(gl); }
                }
                LBAR();
                if (ii + 1 < cnt) GDN_DMA(bh2 >> 2, bh2 & 3, n2);
                if (wave < 6) {
                    const int tl = wave % 3, a = tl >= 1 ? 1 : 0, bb = tl == 2 ? 1 : 0; const bool isqk = wave >= 3;
                    const bf16* Asrc = isqk ? QB : KB; const int r = lane & 31, hh = lane >> 5;
                    f32x16 acc;
#pragma unroll
                    for (int i = 0; i < 16; ++i) acc[i] = 0.f;
#pragma unroll
                    for (int kk = 0; kk < 8; ++kk) { const pg8::bf16x8 af = *(const pg8::bf16x8*)(Asrc + (32 * a + r) * 136 + 16 * kk + 8 * hh), bfr = *(const pg8::bf16x8*)(KB + (32 * bb + r) * 136 + 16 * kk + 8 * hh);
                        acc = __builtin_amdgcn_mfma_f32_32x32x16_bf16(af, bfr, acc, 0, 0, 0); }
                    const int j = 32 * bb + r; const float gcj = GT[64 + j];
                    const int kq = j >> 4, o = j & 15, hh2 = (o >> 2) & 1, jj = ((o >> 3) << 2) | (o & 3);
#pragma unroll
                    for (int reg = 0; reg < 16; ++reg) { const int i = 32 * a + (reg & 3) + 8 * (reg >> 2) + 4 * hh; const float dec = __expf(fminf(GT[64 + i] - gcj, 0.f));
                        if (!isqk) AM[i * 64 + j] = (i > j) ? GT[i] * acc[reg] * dec : 0.f;
                        else { const float val = (i >= j) ? acc[reg] * dec : 0.f; *(bf16*)(QKS + ((a * 4 + kq) * 64 + hh2 * 32 + (i & 31)) * 16 + jj * 2) = (bf16)f2bf(val); } }
                } else {
#pragma unroll 2
                    for (int q = 0; q < 8; ++q) { const int idx = (tid - 384) + 128 * q, blk = idx >> 6, l = idx & 63, r = l & 31, hh = l >> 5, a = blk >> 3, kq = blk & 7, i = 32 * a + r;
                        const v2u lo = *(const v2u*)(QB + i * 136 + 16 * kq + 4 * hh), hi2 = *(const v2u*)(QB + i * 136 + 16 * kq + 8 + 4 * hh); const float eg = GT[128 + i];
                        v4u o4; o4.x = pkbf(bflo(lo.x) * eg, bfhi(lo.x) * eg); o4.y = pkbf(bflo(lo.y) * eg, bfhi(lo.y) * eg); o4.z = pkbf(bflo(hi2.x) * eg, bfhi(hi2.x) * eg); o4.w = pkbf(bflo(hi2.y) * eg, bfhi(hi2.y) * eg);
                        *(v4u*)(blob + (16 + blk) * 1024 + l * 16) = o4; }
                }
                LBAR();
                if (tid < 256) {
                    const int c = tid; const bool isv = c < 128; const bf16* src = isv ? (VB + c) : (KB + (c - 128));
                    float X[64];
                    { const LAS float* AMl = (const LAS float*)AM; const LAS float* GTl = (const LAS float*)GT; const LAS bf16* srcl = (const LAS bf16*)src;
                      asm volatile("" : "+v"(AMl), "+v"(GTl), "+v"(srcl));
                      const float sel_ = isv ? 1.f : 0.f; f32x4 c0[16]; const float y0 = GTl[0] * bf1(srcl[0]) * (sel_ + (1.f - sel_) * GTl[128]);
                      SolveRow<0>::run(X, AMl, GTl, srcl, sel_, c0, y0);
                      if (PROBE_SUB & 32) { asm volatile("" : "+v"(AMl), "+v"(GTl), "+v"(srcl)); SolveRow<0>::run(X, AMl, GTl, srcl, sel_, c0, y0); } }
                    asm volatile("s_waitcnt vmcnt(0)" ::: "memory");
                    if (isv) {
                        const int s4 = c >> 5, cc = c & 31;
#pragma unroll
                        for (int a = 0; a < 2; ++a)
#pragma unroll
                            for (int hh = 0; hh < 2; ++hh) { v4u u0, u1;
                                u0.x = pkbf(X[32 * a + 4 * hh + 0], X[32 * a + 4 * hh + 1]); u0.y = pkbf(X[32 * a + 4 * hh + 2], X[32 * a + 4 * hh + 3]);
                                u0.z = pkbf(X[32 * a + 8 + 4 * hh + 0], X[32 * a + 8 + 4 * hh + 1]); u0.w = pkbf(X[32 * a + 8 + 4 * hh + 2], X[32 * a + 8 + 4 * hh + 3]);
                                u1.x = pkbf(X[32 * a + 16 + 4 * hh + 0], X[32 * a + 16 + 4 * hh + 1]); u1.y = pkbf(X[32 * a + 16 + 4 * hh + 2], X[32 * a + 16 + 4 * hh + 3]);
                                u1.z = pkbf(X[32 * a + 24 + 4 * hh + 0], X[32 * a + 24 + 4 * hh + 1]); u1.w = pkbf(X[32 * a + 24 + 4 * hh + 2], X[32 * a + 24 + 4 * hh + 3]);
                                unsigned char* up = GU + (size_t)it * 16384 + ((s4 * 2 + a) * 64 + hh * 32 + cc) * 32; *(v4u*)up = u0; *(v4u*)(up + 16) = u1; }
                    } else {
                        const int dk = c - 128, kq = dk >> 4, o = dk & 15, hh2 = (o >> 2) & 1, jj = ((o >> 3) << 2) | (o & 3);
#pragma unroll
                        for (int i = 0; i < 64; ++i) *(bf16*)(WNS + (((i >> 5) * 8 + kq) * 64 + hh2 * 32 + (i & 31)) * 16 + jj * 2) = (bf16)f2bf(-X[i]);
                    }
                } else {
                    v4u ok[4], oq[2];
#pragma unroll
                    for (int q = 0; q < 4; ++q) { const int idx = (tid - 256) + 256 * q, blk = idx >> 6, l = idx & 63, r = l & 31, hh = l >> 5, ip = blk >> 2, kq = blk & 3, dk = 32 * ip + r;
                        float vv[8];
#pragma unroll
                        for (int j = 0; j < 8; ++j) { const int tk = 16 * kq + 8 * (j >> 2) + 4 * hh + (j & 3); vv[j] = bf1(KB[tk * 136 + dk]) * GT[192 + tk]; }
                        ok[q].x = pkbf(vv[0], vv[1]); ok[q].y = pkbf(vv[2], vv[3]); ok[q].z = pkbf(vv[4], vv[5]); ok[q].w = pkbf(vv[6], vv[7]); }
#pragma unroll
                    for (int q = 0; q < 2; ++q) { const int idx = (tid - 256) + 256 * q; oq[q] = *(const v4u*)(QKS + idx * 16); }
                    asm volatile("s_waitcnt vmcnt(0)" ::: "memory");
#pragma unroll
                    for (int q = 0; q < 4; ++q) { const int idx = (tid - 256) + 256 * q, blk = idx >> 6, l = idx & 63; *(v4u*)(blob + (40 + blk) * 1024 + l * 16) = ok[q]; }
#pragma unroll
                    for (int q = 0; q < 2; ++q) { const int idx = (tid - 256) + 256 * q; *(v4u*)(blob + 32 * 1024 + idx * 16) = oq[q]; }
                }
                LBAR();
#pragma unroll
                for (int q = 0; q < 2; ++q) { const int idx = tid + 512 * q; *(v4u*)(blob + idx * 16) = *(const v4u*)(WNS + idx * 16); }
            }
            asm volatile("s_waitcnt vmcnt(0)" ::: "memory");
            }
#undef GDN_DMA
        }
}
#undef GDN_ITEM

typedef const Args __attribute__((address_space(4)))* ArgsP;
__device__ __forceinline__ ArgsP launder_args() { ArgsP p = (ArgsP)__builtin_amdgcn_kernarg_segment_ptr(); asm volatile("" : "+s"(p)); return p; }
template <bool FINAL>
__device__ __forceinline__ void lru_pass(unsigned char* lds, ArgsP ap, const bf16* PROJ, float* LEND, bf16* OLRU, const int tid, const int lane, const int wave, const int vb, const int GB, const int nrep) {
    bf16* RAW = (bf16*)lds;
    float* XCf = (float*)(lds + 17408);
    bf16* XCb = (bf16*)(lds + 50176);
    bf16* WAT = (bf16*)(lds + 68608);
    bf16* WXT = (bf16*)(lds + 77824);
    float* AA = (float*)(lds + 87040);
    float* GE = (float*)(lds + 119808);
    bf16* YB = (bf16*)(lds + 123904);
    float* CI = (float*)(lds + 140288);
    const int c = tid & 63, tg = tid >> 6; const int nfix = vb & 7;
    for (int i = tid; i < 4096; i += NTHR) { const int cc = i >> 6, d = i & 63;
        WAT[d * 72 + cc] = (bf16)f2bf(ap->in[I_LWA][(size_t)nfix * 4096 + i]); WXT[d * 72 + cc] = (bf16)f2bf(ap->in[I_LWX][(size_t)nfix * 4096 + i]); }
    const int mt = wave >> 1, nt = wave & 1, r32 = lane & 31, hh = lane >> 5;
    const int dch = nfix * 64 + 32 * nt + r32;
    const float ba_ = ap->in[I_LBA][dch], bx_ = ap->in[I_LBX][dch], sp_ = softplusf_(-ap->in[I_LLAM][dch]);
    const int chc = nfix * 64 + c;
    const float w0 = ap->in[I_LCONVW][chc], w1 = ap->in[I_LCONVW][512 + chc], w2 = ap->in[I_LCONVW][1024 + chc], w3 = ap->in[I_LCONVW][1536 + chc], cb = ap->in[I_LCONVB][chc];
    v4u praw[3], pyb[2];
#define LRU_PREFETCH(tile_) do { const int ck_ = ((tile_) >> 3) % NLCH, b_ = (tile_) / (8 * NLCH); const size_t mm_ = (size_t)b_ * SEQ + ck_ * LCH; \
        _Pragma("unroll") for (int i_ = 0; i_ < 3; ++i_) { const int q_ = tid + 512 * i_, row_ = q_ >> 3, c8_ = q_ & 7; praw[i_] = (v4u){0u, 0u, 0u, 0u}; \
            if (q_ < 1048 && ck_ * LCH - 3 + row_ >= 0) praw[i_] = *(const v4u*)(PROJ + (mm_ - 3 + row_) * NPROJ + C_XB + nfix * 64 + c8_ * 8); } \
        if constexpr (FINAL) { _Pragma("unroll") for (int i_ = 0; i_ < 2; ++i_) { const int q_ = tid + 512 * i_, row_ = q_ >> 3, c8_ = q_ & 7; pyb[i_] = *(const v4u*)(PROJ + (mm_ + row_) * NPROJ + C_YB + nfix * 64 + c8_ * 8); } } } while (0)
    for (int rs_ = 0; rs_ < nrep; ++rs_) {
    int tile = vb;
    if (tile < BATCH * NLCH * 8) LRU_PREFETCH(tile);
    for (; tile < BATCH * NLCH * 8; tile += GB) {
        const int ck = (tile >> 3) % NLCH, b = tile / (8 * NLCH);
        const int ch = nfix * 64 + c, t0 = ck * LCH + tg * 16; const size_t m0 = (size_t)b * SEQ + t0;
#pragma unroll
        for (int i = 0; i < 3; ++i) { const int q = tid + 512 * i; if (q < 1048) *(v4u*)(RAW + q * 8) = praw[i]; }
        __syncthreads();
        if constexpr (FINAL) {
#pragma unroll
            for (int i = 0; i < 2; ++i) *(v4u*)(YB + (tid + 512 * i) * 8) = pyb[i]; }
        if (tile + GB < BATCH * NLCH * 8) LRU_PREFETCH(tile + GB);
        float pv[8], hv[8];
        if constexpr (FINAL) { const float* pe_ = LEND + (size_t)(b * NLCH) * 512 + ch; const float* he_ = pe_ + (size_t)BATCH * NLCH * 512;
#pragma unroll
            for (int q = 0; q < 8; ++q) { const int k2 = tg * 8 + q; const bool ok = k2 < ck; pv[q] = ok ? pe_[(size_t)k2 * 512] : 1.f; hv[q] = ok ? he_[(size_t)k2 * 512] : 0.f; } }
        {
            float win[19];
#pragma unroll
            for (int j = 0; j < 19; ++j) win[j] = bf1(RAW[(tg * 16 + j) * 64 + c]);
#pragma unroll
            for (int j = 0; j < 16; ++j) { const float xc = w0 * win[j] + w1 * win[j + 1] + w2 * win[j + 2] + w3 * win[j + 3] + cb;
                XCf[(tg * 16 + j) * 64 + c] = xc; XCb[(tg * 16 + j) * 72 + c] = (bf16)f2bf(xc); }
        }
        __syncthreads();
        {
            f32x16 aR, aI;
#pragma unroll
            for (int i = 0; i < 16; ++i) { aR[i] = 0.f; aI[i] = 0.f; }
#pragma unroll
            for (int kk = 0; kk < 4; ++kk) { const pg8::bf16x8 af = *(const pg8::bf16x8*)(XCb + (32 * mt + r32) * 72 + 16 * kk + 8 * hh);
                const pg8::bf16x8 bA = *(const pg8::bf16x8*)(WAT + (32 * nt + r32) * 72 + 16 * kk + 8 * hh), bX = *(const pg8::bf16x8*)(WXT + (32 * nt + r32) * 72 + 16 * kk + 8 * hh);
                aR = __builtin_amdgcn_mfma_f32_32x32x16_bf16(af, bA, aR, 0, 0, 0); aI = __builtin_amdgcn_mfma_f32_32x32x16_bf16(af, bX, aI, 0, 0, 0); }
#pragma unroll
            for (int reg = 0; reg < 16; ++reg) { const int tok = 32 * mt + (reg & 3) + 8 * (reg >> 2) + 4 * hh, d = 32 * nt + r32;
                const float r = sigmoidf_(aR[reg] + ba_), ig = sigmoidf_(aI[reg] + bx_);
                const float la = -8.f * r * sp_, a = __expf(la), mult = __builtin_amdgcn_sqrtf(fmaxf(1.f - a * a, 0.f));
                const float xc = XCf[tok * 64 + d]; XCf[tok * 64 + d] = mult * ig * xc; AA[tok * 64 + d] = a; }
        }
        __syncthreads();
        {
            float hl = 0.f, pl = 1.f;
#pragma unroll
            for (int j = 0; j < 16; ++j) { const float a = AA[(tg * 16 + j) * 64 + c], bt = XCf[(tg * 16 + j) * 64 + c]; hl = a * hl + bt; pl *= a; }
            GE[(tg * 64 + c) * 2] = pl; GE[(tg * 64 + c) * 2 + 1] = hl;
            if constexpr (FINAL) { float ps = 1.f, hs = 0.f;
#pragma unroll
                for (int q = 0; q < 8; ++q) { hs = pv[q] * hs + hv[q]; ps *= pv[q]; }
                CI[(tg * 64 + c) * 2] = ps; CI[(tg * 64 + c) * 2 + 1] = hs; }
        }
        __syncthreads();
        if constexpr (!FINAL) {
            if (tg == 0) { float hcc = 0.f, pcc = 1.f;
#pragma unroll
                for (int g = 0; g < 8; ++g) { const float pg = GE[(g * 64 + c) * 2], hg = GE[(g * 64 + c) * 2 + 1]; hcc = pg * hcc + hg; pcc *= pg; }
                LEND[(size_t)((b * NLCH + ck) * 512 + ch)] = pcc; LEND[(size_t)BATCH * NLCH * 512 + (size_t)((b * NLCH + ck) * 512 + ch)] = hcc; }
        } else {
            float hc = 0.f;
#pragma unroll
            for (int g2 = 0; g2 < 8; ++g2) hc = CI[(g2 * 64 + c) * 2] * hc + CI[(g2 * 64 + c) * 2 + 1];
            for (int g = 0; g < tg; ++g) { const float pg = GE[(g * 64 + c) * 2], hg = GE[(g * 64 + c) * 2 + 1]; hc = pg * hc + hg; }
            float h = hc;
#pragma unroll
            for (int j = 0; j < 16; ++j) { const float a = AA[(tg * 16 + j) * 64 + c], bt = XCf[(tg * 16 + j) * 64 + c]; h = a * h + bt;
                const float yv = bf1(YB[(tg * 16 + j) * 64 + c]);
                OLRU[(m0 + j) * 1024 + ch] = (bf16)f2bf(h * gelu_tanh_(yv)); }
        }
    }
    __syncthreads();
    }
#undef LRU_PREFETCH
}

#define PHASE_PTRS \
    int tid = threadIdx.x; asm volatile("" : "+v"(tid)); const int lane = tid & 63, wave = __builtin_amdgcn_readfirstlane(tid >> 6); \
    const int G = gridDim.x, bid = blockIdx.x; const int vcu = (G % 8 == 0) ? (bid % 8) * (G / 8) + bid / 8 : bid; \
    const int gw = vcu * NWAVES + wave, NGW = G * NWAVES; (void)lane; (void)gw; (void)NGW; \
    ArgsP ap = launder_args(); unsigned char* ws = ap->ws; unsigned* ctl = (unsigned*)(ws + WS_CTL); \
    const float* x = ap->in[I_X]; float* MOD = (float*)(ws + WS_MOD); float* BA = (float*)(ws + WS_BA); float* BG = (float*)(ws + WS_BG); \
    bf16* H = (bf16*)(ws + WS_H); bf16* PROJ = (bf16*)(ws + WS_PROJ); bf16* OGDN = (bf16*)(ws + WS_OCAT); bf16* OLRU = (bf16*)(ws + WS_OCAT) + 512; \
    bf16* HLOC = (bf16*)(ws + WS_HLOC); bf16* PLOC = (bf16*)(ws + WS_PLOC); float* LEND = (float*)(ws + WS_LEND); \
    bf16* MERGED = (bf16*)(ws + WS_MERGED); bf16* X2 = (bf16*)(ws + WS_X2); int* TOPI = (int*)(ws + WS_TOPI); float* TOPW = (float*)(ws + WS_TOPW); \
    int* LIST = (int*)(ws + WS_LIST); bf16* XS = (bf16*)(ws + WS_XS); bf16* ACT = (bf16*)(ws + WS_ACT); bf16* Y = (bf16*)(ws + WS_Y); \
    unsigned* CNT = ctl + CW_CNT; \
    (void)x; (void)MOD; (void)BA; (void)BG; (void)H; (void)PROJ; (void)OGDN; (void)OLRU; (void)HLOC; (void)PLOC; (void)LEND; (void)MERGED; (void)X2; (void)TOPI; (void)TOPW; (void)LIST; (void)XS; (void)ACT; (void)Y; (void)CNT;
__global__ void __launch_bounds__(NTHR, 2) mk_fwd(Args args) {
    extern __shared__ __attribute__((aligned(16))) unsigned char lds[];
    const int tid0 = threadIdx.x;
    unsigned* ctl0 = (unsigned*)(args.ws + WS_CTL);
    volatile LAS unsigned* MISC = (volatile LAS unsigned*)((LAS unsigned char*)lds + MISC_OFF);
    for (int u = tid0; u < (LDS_BYTES - LDSCTL_OFF) / 4; u += NTHR) ((LAS unsigned*)((LAS unsigned char*)lds + LDSCTL_OFF))[u] = 0u;
    __syncthreads();
    XcdBarrier bar; bar.bar = ctl0 + CW_BAR; bar.x = 0; bar.st = nullptr;
    if (N_LAUNCHES == 1) bar = xcd_barrier_post(ctl0 + CW_BAR, MISC + 8);
    const int lo = args.ph_lo, hi = args.ph_hi;
#ifndef PH_MASK
#define PH_MASK 0x1fff
#endif
#define IN(k) (((PH_MASK >> (k)) & 1) && lo <= (k) && (k) < hi)
#ifndef PROBE_DUP
#define PROBE_DUP 0
#endif
#ifndef TR_IN_P0
#define TR_IN_P0 0
#endif
#define NREP(k) ((((PROBE_DUP) >> (k)) & 1) ? 2 : 1)
#define SEAM(k) do { if (IN(k) && IN((k) + 1)) xcd_barrier(bar); } while (0)

    for (int rep_ = 0; rep_ < NREP(0); ++rep_) { if (IN(0)) {
        PHASE_PTRS
        {
            float* cact = (float*)lds;
            float* red = (float*)(lds + 16384);
            if (bid < 192) {
                for (int i = tid; i < 4096; i += NTHR) cact[i] = siluf_(ap->in[I_C][i]);
                __syncthreads();
                const int col = tid & 31, kg = tid >> 5; const float* wp = ap->in[I_WADA] + 32 * bid + col;
                float a0 = 0.f, a1 = 0.f, a2 = 0.f, a3 = 0.f;
                float wv[64];
#pragma unroll
                for (int i = 0; i < 64; ++i) wv[i] = wp[(size_t)(kg + 16 * i) * 6144];
                __builtin_amdgcn_sched_barrier(0);
#pragma unroll
                for (int i = 0; i < 64; ++i) { const int k = kg + 16 * i; const float w = wv[i];
                    a0 += cact[k] * w; a1 += cact[1024 + k] * w; a2 += cact[2048 + k] * w; a3 += cact[3072 + k] * w; }
                red[(kg * 4 + 0) * 32 + col] = a0; red[(kg * 4 + 1) * 32 + col] = a1; red[(kg * 4 + 2) * 32 + col] = a2; red[(kg * 4 + 3) * 32 + col] = a3;
                __syncthreads();
                if (tid < 128) { const int b = tid >> 5, c2 = tid & 31; float s = 0.f;
                    for (int g = 0; g < 16; ++g) s += red[(g * 4 + b) * 32 + c2];
                    MOD[b * 6144 + 32 * bid + c2] = s + ap->in[I_BADA][32 * bid + c2]; }
            }
            __syncthreads();
        }
        float* scr = (float*)(lds + wave * 16384);
        constexpr int IT_A = 16 * 64, IT_B = 16 * 32, IT_G = 16 * 16 * 4, IT_BG = 8 * 32, IT_O = 16 * 32, IT_1 = 16 * 64, IT_2 = 16 * 32;
        constexpr int NIT = IT_A + IT_B + IT_G + 2 * IT_BG + IT_O;
        for (int it = gw; it < NIT; it += NGW) {
            int r = it;
            if (r < IT_A) { p0_transpose_item(ap->in[I_WIN], DIN, D, 64, (bf16*)(ws + WS_WIN), scr, r, lane); continue; } r -= IT_A;
            if (r < IT_B) { p0_transpose_item(ap->in[I_WIN] + 2056, DIN, D, 32, (bf16*)(ws + WS_WIN) + (size_t)2048 * D, scr, r, lane); continue; } r -= IT_B;
            if (r < IT_G) { const int seg = r >> 6, j = seg >> 1, gl_ = seg & 1;
                p0_transpose_item(ap->in[I_WIN] + 2056 + 1024 + gl_ * 1024 + 128 * j, DIN, D, 4, (bf16*)(ws + WS_WIN) + (size_t)(C_GT + 256 * j + 128 * gl_) * D, scr, r & 63, lane); continue; } r -= IT_G;
            if (r < IT_BG) { p0_transpose_item(ap->in[I_WBG], D, 1024, 32, (bf16*)(ws + WS_WBG), scr, r, lane); continue; } r -= IT_BG;
            if (r < IT_BG) { p0_transpose_item(ap->in[I_WBL], D, 1024, 32, (bf16*)(ws + WS_WBG) + 512, scr, r, lane); continue; } r -= IT_BG;
            { p0_transpose_item(ap->in[I_WOUT], D, D, 32, (bf16*)(ws + WS_WOUT), scr, r, lane); }
        }
        if (TR_IN_P0) { constexpr int IT_1b = 16 * 64, IT_2b = 16 * 32;
            for (int it = gw; it < NE * (IT_1b + IT_2b); it += NGW) {
                if (it < NE * IT_1b) { const int e = it / IT_1b; p0_transpose_item(ap->in[I_W1] + (size_t)e * D * 2048, 2048, D, 64, (bf16*)(ws + WS_W1) + (size_t)e * 2048 * D, scr, it % IT_1b, lane); }
                else { const int r = it - NE * IT_1b, e = r / IT_2b; p0_transpose_item(ap->in[I_W2] + (size_t)e * FF * D, D, FF, 32, (bf16*)(ws + WS_W2) + (size_t)e * D * FF, scr, r % IT_2b, lane); } } }
    }
    SEAM(0); }

    for (int rep_ = 0; rep_ < NREP(1); ++rep_) { if (IN(1)) {
        PHASE_PTRS
        {
            bf16* WGH = (bf16*)(ws + WS_WGH); bf16* WGL = (bf16*)(ws + WS_WGL); float* CB = (float*)(ws + WS_CB);
            const float* wr = ap->in[I_WR]; const float* nf = ap->in[I_NFFN];
            for (int i = vcu * NTHR + tid; i < 4 * 32 * 1024; i += G * NTHR) { const int b = i >> 15, e = (i >> 10) & 31, k = i & 1023;
                const float val = wr[k * 32 + e] * nf[k] * (1.f + MOD[b * 6144 + 4096 + k]); const unsigned hi = f2bf(val); const float lo = val - bf1((bf16)hi);
                WGH[i] = (bf16)hi; WGL[i] = (bf16)f2bf(lo); }
            if (gw < 128) { const int b = gw >> 5, e = gw & 31; float a = 0.f;
                for (int k = lane; k < 1024; k += 64) a += MOD[b * 6144 + 3072 + k] * wr[k * 32 + e];
                a = wave_sum(a); if (lane == 0) CB[gw] = a + ap->in[I_BR][e]; }
        }
        float* w8 = (float*)lds;
        for (int i = tid; i < 8192; i += NTHR) w8[i] = ap->in[I_WIN][(size_t)(i >> 3) * DIN + 2048 + (i & 7)];
        __syncthreads();
        const float* nm = ap->in[I_NMIX];
        f32x4 xq[4], xn[4];
#define P1_LOAD(dst_, m_) do { const float* xr_ = x + (size_t)(m_) * D; _Pragma("unroll") for (int c_ = 0; c_ < 2; ++c_) _Pragma("unroll") for (int q_ = 0; q_ < 2; ++q_) dst_[c_ * 2 + q_] = *(const f32x4*)(xr_ + c_ * 512 + lane * 8 + q_ * 4); } while (0)
        int bcur = -1; float gq[16], sq[16];
        f32x4 wreg[16][2];
#pragma unroll
        for (int c = 0; c < 2; ++c)
#pragma unroll
            for (int j = 0; j < 8; ++j) { const int k = c * 512 + lane * 8 + j; wreg[c * 8 + j][0] = *(const f32x4*)(w8 + k * 8); wreg[c * 8 + j][1] = *(const f32x4*)(w8 + k * 8 + 4); }
        int m = gw;
        if (m < M) { P1_LOAD(xq, m); const int m1 = m + NGW < M ? m + NGW : m; P1_LOAD(xn, m1); }
        for (; m < M; m += NGW) {
            const int b = m >> 13;
            if (b != bcur) { bcur = b; const float* md = MOD + b * 6144;
#pragma unroll
                for (int c = 0; c < 2; ++c)
#pragma unroll
                    for (int j = 0; j < 8; ++j) { const int k = c * 512 + lane * 8 + j; gq[c * 8 + j] = nm[k] * (1.f + md[1024 + k]); sq[c * 8 + j] = md[k]; } }
            float v[16]; float ss = 0.f;
#pragma unroll
            for (int i = 0; i < 4; ++i)
#pragma unroll
                for (int j = 0; j < 4; ++j) { v[i * 4 + j] = xq[i][j]; ss += xq[i][j] * xq[i][j]; }
#pragma unroll
            for (int i = 0; i < 4; ++i) xq[i] = xn[i];
            { const int mn = m + 2 * NGW < M ? m + 2 * NGW : m; P1_LOAD(xn, mn); }
            const float rstd = rsqrtf(wave_sum(ss) * (1.f / D) + EPS);
            float hh[16]; float d8[8] = {0.f, 0.f, 0.f, 0.f, 0.f, 0.f, 0.f, 0.f};
#pragma unroll
            for (int c = 0; c < 2; ++c) {
#pragma unroll
                for (int j = 0; j < 8; ++j) { const int k = c * 512 + lane * 8 + j;
                    const float hv = v[c * 8 + j] * rstd * gq[c * 8 + j] + sq[c * 8 + j]; hh[c * 8 + j] = hv;
                    const f32x4 wa = wreg[c * 8 + j][0], wb = wreg[c * 8 + j][1];
                    d8[0] += hv * wa[0]; d8[1] += hv * wa[1]; d8[2] += hv * wa[2]; d8[3] += hv * wa[3]; d8[4] += hv * wb[0]; d8[5] += hv * wb[1]; d8[6] += hv * wb[2]; d8[7] += hv * wb[3]; }
                v4u o; o.x = pk2(hh[c * 8 + 0], hh[c * 8 + 1]); o.y = pk2(hh[c * 8 + 2], hh[c * 8 + 3]); o.z = pk2(hh[c * 8 + 4], hh[c * 8 + 5]); o.w = pk2(hh[c * 8 + 6], hh[c * 8 + 7]);
                *(v4u*)(H + (size_t)m * D + c * 512 + lane * 8) = o; }
#pragma unroll
            for (int j = 0; j < 4; ++j) { const bool up = (lane & 32) != 0; const float send = up ? d8[j] : d8[j + 4]; const float keep = up ? d8[j + 4] : d8[j]; d8[j] = keep + __shfl_xor(send, 32); }
#pragma unroll
            for (int j = 0; j < 2; ++j) { const bool up = (lane & 16) != 0; const float send = up ? d8[j] : d8[j + 2]; const float keep = up ? d8[j + 2] : d8[j]; d8[j] = keep + __shfl_xor(send, 16); }
            { const bool up = (lane & 8) != 0; const float send = up ? d8[0] : d8[1]; const float keep = up ? d8[1] : d8[0]; d8[0] = keep + __shfl_xor(send, 8); }
            float dv = d8[0]; dv += __shfl_xor(dv, 4); dv += __shfl_xor(dv, 2); dv += __shfl_xor(dv, 1);
            if ((lane & 7) == 0) BA[(size_t)m * 8 + (lane >> 3)] = dv;
        }
#undef P1_LOAD
        __syncthreads();
    }
    SEAM(1); }

    for (int rep_ = 0; rep_ < NREP(2); ++rep_) { if (IN(2)) {
        PHASE_PTRS
        SchedDense S{(const char*)H, (const char*)(ws + WS_WIN), M / 256, NPROJ / 256, G, bid, D};
        EpiProj E{PROJ};
        pg8::gemm_phase<EpiProj, SchedDense, true>((LAS unsigned char*)lds, D, S, E, tid);
    }
    SEAM(2); }

    for (int rep_ = 0; rep_ < NREP(3); ++rep_) { if (IN(3)) {
        PHASE_PTRS
        gdn_prep_items(lds, ws, PROJ, BA, ap->in[I_GCONV], ap->in[I_GALOG], ap->in[I_GDT], 0, vcu, G, NSPLIT / 16);

    }
    SEAM(3); }

    for (int rep_ = 0; rep_ < NREP(4); ++rep_) { if (IN(4)) {
        PHASE_PTRS
        constexpr int NSCAN = 32;
        const bool xmap = (G % 8 == 0) && G >= 64;
        const bool is_scan = xmap ? (bid < NSCAN) : (vcu < NSCAN);
        const int sj_ = xmap ? (bid >> 3) : (vcu >> 4) * 2 + ((vcu >> 3) & 1);
        const int sbh = xmap ? (((bid & 7) << 1) | (sj_ & 1)) : (vcu & 15), shf = xmap ? (sj_ >> 1) : (vcu >> 4);
        const int vbn = xmap ? bid - NSCAN : vcu - NSCAN, nbn = G - NSCAN;
        if (is_scan) { for (int rs4_ = 0; rs4_ < ((PROBE_SUB & 4) ? 2 : 1); ++rs4_) {
            const int bh = sbh, hf = shf, b = bh >> 2, h = bh & 3;
            const unsigned char* gblob = ws + WS_GBLOB + (size_t)bh * 128 * 57344;
            const unsigned char* gub = ws + WS_GU + (size_t)bh * 128 * 16384;
            LAS unsigned char* L = (LAS unsigned char*)lds;
            constexpr int STEPB = 73728;
            if (wave >= 4) {
                const int lw = wave - 4;
#define RING_ISSUE(nn__, ty_) do { int n_ = (nn__); const int bo_ = (n_ & 1) * STEPB; n_ = n_ < 128 ? n_ : 127; \
                    const unsigned char* src_ = ((ty_) == 0) ? gub + (size_t)n_ * 16384 : gblob + (size_t)n_ * 57344 + ((ty_) == 1 ? 0 : (ty_) == 2 ? 16384 : (ty_) == 3 ? 32768 : 40960); \
                    LAS unsigned char* dst_ = L + bo_ + ((ty_) == 0 ? 0 : (ty_) == 1 ? 16384 : (ty_) == 2 ? 32768 : (ty_) == 3 ? 49152 : 57344); const int nq_ = ((ty_) == 3 || (ty_) == 0) ? 2 : 4; \
                    for (int q_ = 0; q_ < nq_; ++q_) { const int blk_ = ((ty_) == 0 ? 8 * hf : 0) + lw + 4 * q_;     __builtin_amdgcn_global_load_lds((const unsigned*)(src_ + blk_ * 1024 + lane * 16), (LAS unsigned*)(dst_ + blk_ * 1024), 16, 0, 0); } } while (0)
#define RING_BAR(nv_) do { asm volatile("s_waitcnt vmcnt(" #nv_ ")" ::: "memory"); __builtin_amdgcn_s_barrier(); asm volatile("" ::: "memory"); } while (0)
                RING_ISSUE(0, 0); RING_ISSUE(0, 1); RING_ISSUE(0, 2); RING_ISSUE(0, 3); RING_ISSUE(0, 4); RING_ISSUE(1, 0); RING_ISSUE(1, 1); RING_ISSUE(1, 2); RING_ISSUE(1, 3);
                for (int n = 0; n < 128; ++n) {
                    if (n >= NSPLIT - 2 && n + 2 < 128 && (n + 2 == NSPLIT || (n + 2 - NSPLIT >= SG0 && ((n + 2 - NSPLIT - SG0) % SGC) == 0))) {
                        const int s_ = gdn_stage_of(n + 2 - NSPLIT);
                        const unsigned want = (unsigned)nbn * (unsigned)(rep_ + 1); unsigned sp = 0;
                        while (__hip_atomic_load(ctl + CW_GDN2 + s_, RLX_AGENT) < want) { __builtin_amdgcn_s_sleep(2); if (++sp > (1u << 22)) break; }
                        __builtin_amdgcn_fence(__ATOMIC_ACQUIRE, "agent"); asm volatile("s_waitcnt vmcnt(0)" ::: "memory"); }
                    RING_BAR(22); RING_ISSUE(n + 1, 4);
                    RING_BAR(22); RING_ISSUE(n + 2, 0); RING_ISSUE(n + 2, 1);
                    RING_BAR(26); RING_ISSUE(n + 2, 2);
                    RING_BAR(26); RING_ISSUE(n + 2, 3);
                }
                asm volatile("s_waitcnt vmcnt(0)" ::: "memory");
#undef RING_ISSUE
#undef RING_BAR
            } else if (wave >= 2) {
                for (int n = 0; n < 128; ++n) { __builtin_amdgcn_s_barrier(); __builtin_amdgcn_s_barrier(); __builtin_amdgcn_s_barrier(); __builtin_amdgcn_s_barrier(); }
            } else {
                const int sl = 2 * hf + wave, c = lane & 31, hh = lane >> 5;
                f32x16 S[4];
#pragma unroll
                for (int i = 0; i < 4; ++i)
#pragma unroll
                    for (int r = 0; r < 16; ++r) S[i][r] = 0.f;
                bf16* og = OGDN + ((size_t)b * SEQ) * 1024 + h * 128 + 32 * sl + c;
#define CBAR() do { asm volatile("" ::: "memory"); __builtin_amdgcn_s_barrier(); asm volatile("" ::: "memory"); } while (0)
#define AFR(base, blk) (*(const LAS pg8::bf16x8*)((base) + (blk) * 1024))
                for (int n = 0; n < 128; ++n) {
                    const LAS unsigned char* sb_ = L + (n & 1) * STEPB;
                    const LAS unsigned char* pU = sb_ + ((sl * 2) * 64 + lane) * 32;
                    const LAS unsigned char* pW = sb_ + 16384 + lane * 16;
                    const LAS unsigned char* pQ = sb_ + 32768 + lane * 16;
                    const LAS unsigned char* pK = sb_ + 49152 + lane * 16;
                    const LAS unsigned char* pD = sb_ + 57344 + lane * 16;
                    pg8::bf16x8 Sb[4][2];
#pragma unroll
                    for (int i = 0; i < 4; ++i)
#pragma unroll
                        for (int t = 0; t < 2; ++t) { v4u p; p.x = pkbf(S[i][8 * t], S[i][8 * t + 1]); p.y = pkbf(S[i][8 * t + 2], S[i][8 * t + 3]); p.z = pkbf(S[i][8 * t + 4], S[i][8 * t + 5]); p.w = pkbf(S[i][8 * t + 6], S[i][8 * t + 7]); Sb[i][t] = __builtin_bit_cast(pg8::bf16x8, p); }
                    CBAR();
                    f32x16 vn[2];
#pragma unroll
                    for (int a = 0; a < 2; ++a) { const v4u w0 = *(const LAS v4u*)(pU + a * 2048), w1 = *(const LAS v4u*)(pU + a * 2048 + 16);
                        vn[a][0] = bflo(w0.x); vn[a][1] = bfhi(w0.x); vn[a][2] = bflo(w0.y); vn[a][3] = bfhi(w0.y); vn[a][4] = bflo(w0.z); vn[a][5] = bfhi(w0.z); vn[a][6] = bflo(w0.w); vn[a][7] = bfhi(w0.w);
                        vn[a][8] = bflo(w1.x); vn[a][9] = bfhi(w1.x); vn[a][10] = bflo(w1.y); vn[a][11] = bfhi(w1.y); vn[a][12] = bflo(w1.z); vn[a][13] = bfhi(w1.z); vn[a][14] = bflo(w1.w); vn[a][15] = bfhi(w1.w); }
#pragma unroll
                    for (int a = 0; a < 2; ++a)
#pragma unroll
                        for (int kq = 0; kq < 8; ++kq) vn[a] = __builtin_amdgcn_mfma_f32_32x32x16_bf16(AFR(pW, a * 8 + kq), Sb[kq >> 1][kq & 1], vn[a], 0, 0, 0);
                    CBAR();
                    f32x16 o[2];
#pragma unroll
                    for (int a = 0; a < 2; ++a)
#pragma unroll
                        for (int r = 0; r < 16; ++r) o[a][r] = 0.f;
#pragma unroll
                    for (int a = 0; a < 2; ++a)
#pragma unroll
                        for (int kq = 0; kq < 8; ++kq) o[a] = __builtin_amdgcn_mfma_f32_32x32x16_bf16(AFR(pQ, a * 8 + kq), Sb[kq >> 1][kq & 1], o[a], 0, 0, 0);
                    pg8::bf16x8 Vb[2][2];
#pragma unroll
                    for (int a = 0; a < 2; ++a)
#pragma unroll
                        for (int t = 0; t < 2; ++t) { v4u p; p.x = pkbf(vn[a][8 * t], vn[a][8 * t + 1]); p.y = pkbf(vn[a][8 * t + 2], vn[a][8 * t + 3]); p.z = pkbf(vn[a][8 * t + 4], vn[a][8 * t + 5]); p.w = pkbf(vn[a][8 * t + 6], vn[a][8 * t + 7]); Vb[a][t] = __builtin_bit_cast(pg8::bf16x8, p); }
                    CBAR();
                    const float glc = *(const LAS float*)(sb_ + 49152 + 2048);
#pragma unroll
                    for (int kq = 0; kq < 2; ++kq) o[0] = __builtin_amdgcn_mfma_f32_32x32x16_bf16(AFR(pK, kq), Vb[kq >> 1][kq & 1], o[0], 0, 0, 0);
#pragma unroll
                    for (int kq = 0; kq < 4; ++kq) o[1] = __builtin_amdgcn_mfma_f32_32x32x16_bf16(AFR(pK, 4 + kq), Vb[kq >> 1][kq & 1], o[1], 0, 0, 0);
#pragma unroll
                    for (int i = 0; i < 4; ++i)
#pragma unroll
                        for (int r = 0; r < 16; ++r) S[i][r] *= glc;
                    CBAR();
#pragma unroll
                    for (int i = 0; i < 4; ++i)
#pragma unroll
                        for (int kq = 0; kq < 4; ++kq) S[i] = __builtin_amdgcn_mfma_f32_32x32x16_bf16(AFR(pD, i * 4 + kq), Vb[kq >> 1][kq & 1], S[i], 0, 0, 0);
                    bf16* on = og + (size_t)(n * 64) * 1024;
#pragma unroll
                    for (int a = 0; a < 2; ++a)
#pragma unroll
                        for (int r = 0; r < 16; ++r) on[(size_t)(32 * a + (r & 3) + 8 * (r >> 2) + 4 * hh) * 1024] = (bf16)(pkbf(o[a][r], 0.f) & 0xffffu);
                }
#undef AFR
#undef CBAR
            }
            if (PROBE_SUB & 4) __syncthreads(); }
        } else {
            {
                const int vb0 = vbn, nb0 = nbn; constexpr int NIT2 = 16 * (128 - NSPLIT); const int cnt1 = vb0 < NIT2 ? (NIT2 - vb0 + nb0 - 1) / nb0 : 0;
                static_assert(NSTG == 1 + (128 - NSPLIT - SG0 + SGC - 1) / SGC && NSTG <= 8, "stage count");
                gdn_prep_items(lds, ws, PROJ, BA, ap->in[I_GCONV], ap->in[I_GALOG], ap->in[I_GDT], 1, vb0, nb0, cnt1, ctl);
                asm volatile("s_waitcnt vmcnt(0)" ::: "memory");
                __syncthreads();
                if (tid == 0) {
                    const int s0_ = cnt1 > 0 ? gdn_stage_of((vb0 + nb0 * (cnt1 - 1)) >> 4) : 0;
                    __builtin_amdgcn_fence(__ATOMIC_RELEASE, "agent"); asm volatile("s_waitcnt vmcnt(0)" ::: "memory");
                    for (int s_ = s0_; s_ < NSTG; ++s_) __hip_atomic_fetch_add(ctl + CW_GDN2 + s_, 1u, RLX_AGENT); }
            }
            const bool tr_first = (vbn & 1) != 0;
            if (tr_first) {
            {
                LAS unsigned char* Tl = (LAS unsigned char*)lds + wave * 16384;
                constexpr int IT_1 = 16 * 32, IT_2 = 16 * 16, NITM = NE * (IT_1 + IT_2);
                const int gw2 = vbn * NWAVES + wave, NGW2 = nbn * NWAVES;
                const float* w1p = ap->in[I_W1]; const float* w2p = ap->in[I_W2]; bf16* W1T = (bf16*)(ws + WS_W1); bf16* W2T = (bf16*)(ws + WS_W2);
#define MOE_TR_ITEM(t_, it_) do { const int i_ = (it_); if (i_ < NE * IT_1) { const int e_ = i_ / IT_1, r_ = i_ % IT_1; t_ = TrItem{w1p + (size_t)e_ * D * 2048, W1T + (size_t)e_ * 2048 * D, 2048, D, 64 * (r_ / 32), 64 * (r_ % 32)}; } \
                    else { const int q_ = i_ - NE * IT_1, e_ = q_ / IT_2, r_ = q_ % IT_2; t_ = TrItem{w2p + (size_t)e_ * FF * D, W2T + (size_t)e_ * D * FF, D, FF, 64 * (r_ / 16), 64 * (r_ % 16)}; } } while (0)
                for (int rs8_ = 0; rs8_ < ((PROBE_SUB & 8) ? 2 : 1); ++rs8_) {
                    f32x4 va[16], vb[16]; TrItem ta, tb;
                    { MOE_TR_ITEM(ta, gw2); tr64_load(ta, va, lane); }
                    for (int it = gw2; it < NITM; it += 2 * NGW2) {
                        { const int ib = it + NGW2 < NITM ? it + NGW2 : NITM - 1; MOE_TR_ITEM(tb, ib); tr64_load(tb, vb, lane); }
                        tr64_finish(ta, va, Tl, lane);
                        { const int ia = it + 2 * NGW2 < NITM ? it + 2 * NGW2 : NITM - 1; MOE_TR_ITEM(ta, ia); tr64_load(ta, va, lane); }
                        tr64_finish(tb, vb, Tl, lane);
                    }
                }
#undef MOE_TR_ITEM
            }
            __syncthreads();
            }
            lru_pass<false>(lds, ap, PROJ, LEND, OLRU, tid, lane, wave, vbn, nbn, (PROBE_SUB & 2) ? 2 : 1);
            {
                asm volatile("s_waitcnt vmcnt(0)" ::: "memory");
                __syncthreads();
                if (tid == 0) { __builtin_amdgcn_fence(__ATOMIC_RELEASE, "agent"); asm volatile("s_waitcnt vmcnt(0)" ::: "memory"); __hip_atomic_fetch_add(ctl + CW_LRU, 1u, RLX_AGENT); }
            }
            if (!tr_first) {
            __syncthreads();
            {
                LAS unsigned char* Tl = (LAS unsigned char*)lds + wave * 16384;
                constexpr int IT_1 = 16 * 32, IT_2 = 16 * 16, NITM = NE * (IT_1 + IT_2);
                const int gw2 = vbn * NWAVES + wave, NGW2 = nbn * NWAVES;
                const float* w1p = ap->in[I_W1]; const float* w2p = ap->in[I_W2]; bf16* W1T = (bf16*)(ws + WS_W1); bf16* W2T = (bf16*)(ws + WS_W2);
#define MOE_TR_ITEM(t_, it_) do { const int i_ = (it_); if (i_ < NE * IT_1) { const int e_ = i_ / IT_1, r_ = i_ % IT_1; t_ = TrItem{w1p + (size_t)e_ * D * 2048, W1T + (size_t)e_ * 2048 * D, 2048, D, 64 * (r_ / 32), 64 * (r_ % 32)}; } \
                    else { const int q_ = i_ - NE * IT_1, e_ = q_ / IT_2, r_ = q_ % IT_2; t_ = TrItem{w2p + (size_t)e_ * FF * D, W2T + (size_t)e_ * D * FF, D, FF, 64 * (r_ / 16), 64 * (r_ % 16)}; } } while (0)
                for (int rs8_ = 0; rs8_ < ((PROBE_SUB & 8) ? 2 : 1); ++rs8_) {
                    f32x4 va[16], vb[16]; TrItem ta, tb;
                    { MOE_TR_ITEM(ta, gw2); tr64_load(ta, va, lane); }
                    for (int it = gw2; it < NITM; it += 2 * NGW2) {
                        { const int ib = it + NGW2 < NITM ? it + NGW2 : NITM - 1; MOE_TR_ITEM(tb, ib); tr64_load(tb, vb, lane); }
                        tr64_finish(ta, va, Tl, lane);
                        { const int ia = it + 2 * NGW2 < NITM ? it + 2 * NGW2 : NITM - 1; MOE_TR_ITEM(ta, ia); tr64_load(ta, va, lane); }
                        tr64_finish(tb, vb, Tl, lane);
                    }
                }
#undef MOE_TR_ITEM
            }
            }
            {
                if (tid == 0) { const unsigned want = (unsigned)nbn * (unsigned)(rep_ + 1); unsigned sp = 0;
                    while (__hip_atomic_load(ctl + CW_LRU, RLX_AGENT) < want) { __builtin_amdgcn_s_sleep(2); if (++sp > (1u << 22)) break; }
                    __builtin_amdgcn_fence(__ATOMIC_ACQUIRE, "agent"); asm volatile("s_waitcnt vmcnt(0)" ::: "memory"); }
                __syncthreads();
            }
            lru_pass<true>(lds, ap, PROJ, LEND, OLRU, tid, lane, wave, vbn, nbn, 1);
        }
    }
    SEAM(4); }

    for (int rep_ = 0; rep_ < NREP(5); ++rep_) { if (IN(5)) {
        PHASE_PTRS
        const float* nw = ap->in[I_GNORM]; const float nw0 = nw[2 * lane], nw1 = nw[2 * lane + 1];
        unsigned oq[4], zq[4];
#define P5_LOAD(m_) do { _Pragma("unroll") for (int h_ = 0; h_ < 4; ++h_) { oq[h_] = *(const unsigned*)(OGDN + (size_t)(m_) * 1024 + h_ * 128 + 2 * lane); zq[h_] = *(const unsigned*)(PROJ + (size_t)(m_) * NPROJ + C_Z + h_ * 128 + 2 * lane); } } while (0)
        int m = gw;
        if (m < M) P5_LOAD(m);
        for (; m < M; m += NGW) {
            unsigned ow[4], zw[4];
#pragma unroll
            for (int h = 0; h < 4; ++h) { ow[h] = oq[h]; zw[h] = zq[h]; }
            { const int mn = m + NGW < M ? m + NGW : m; P5_LOAD(mn); }
#pragma unroll
            for (int h = 0; h < 4; ++h) { const float o0 = bflo(ow[h]), o1 = bfhi(ow[h]);
                const float sc = rsqrtf(wave_sum(o0 * o0 + o1 * o1) * (1.f / 128.f) + EPS);
                *(unsigned*)(OGDN + (size_t)m * 1024 + h * 128 + 2 * lane) = pk2(o0 * sc * nw0 * siluf_(bflo(zw[h])), o1 * sc * nw1 * siluf_(bfhi(zw[h]))); }
        }
#undef P5_LOAD
    }
    SEAM(5); if (PROBE_SUB & 16) { for (int q_ = 0; q_ < 8; ++q_) xcd_barrier(bar); } }

    for (int rep_ = 0; rep_ < NREP(6); ++rep_) { if (IN(6)) {
        PHASE_PTRS
        SchedDense S{(const char*)OGDN, (const char*)(ws + WS_WBG), M / 256, D / 256, G, bid, D};
        EpiBranch E{MERGED, PROJ};
        pg8::gemm_phase<EpiBranch, SchedDense, true>((LAS unsigned char*)lds, D, S, E, tid);
    }
    SEAM(6); }

    for (int rep_ = 0; rep_ < NREP(7); ++rep_) { if (IN(7)) {
        PHASE_PTRS
        SchedDense S{(const char*)MERGED, (const char*)(ws + WS_WOUT), M / 256, D / 256, G, bid, D};
        EpiOut E{X2, x, MOD};
        pg8::gemm_phase<EpiOut, SchedDense, true>((LAS unsigned char*)lds, D, S, E, tid);
    }
    SEAM(7); }

    for (int rep_ = 0; rep_ < NREP(8); ++rep_) { if (IN(8)) {
        PHASE_PTRS
        if (NREP(8) > 1 && rep_ == 1) { if (bid == 0 && tid < 32) __hip_atomic_store(CNT + tid, 0u, RLX_AGENT); xcd_barrier(bar); }
        constexpr int TP = 2064, TBY = 32 * TP;
        LAS unsigned char* TB = (LAS unsigned char*)lds;
        float* RS = (float*)(lds + 2 * TBY);
        int* lcnt = (int*)(lds + AUX_OFF);
        int* lbase = lcnt + 32;
        int* lent = lbase + 32;
        const bf16* WGH = (const bf16*)(ws + WS_WGH); const bf16* WGL = (const bf16*)(ws + WS_WGL); const float* CB = (const float*)(ws + WS_CB);
#define P8_DMA(g_, buf_) do { const bf16* src_ = X2 + (size_t)(rb * 128 + (g_) * 32) * D; \
            for (int q_ = 0; q_ < 8; ++q_) { const int p_ = wave + 8 * q_; \
                __builtin_amdgcn_global_load_lds((const unsigned*)(src_ + (size_t)(p_ >> 1) * D + (p_ & 1) * 512 + lane * 8), (LAS unsigned*)(TB + (buf_) * TBY + (p_ >> 1) * TP + (p_ & 1) * 1024), 16, 0, 0); } } while (0)
        for (int rb = vcu; rb < M / 128; rb += G) {
            const int b = (rb * 128) >> 13; const float* md = MOD + b * 6144; const float* nf = ap->in[I_NFFN];
            if (tid < 32) lcnt[tid] = 0;
            P8_DMA(0, 0);
            float gq[8], sq[8];
#pragma unroll
            for (int j = 0; j < 8; ++j) { const int k = 128 * wave + 8 * (lane & 15) + j; gq[j] = nf[k] * (1.f + md[4096 + k]); sq[j] = md[3072 + k]; }
            pg8::bf16x8 wh[8], wl[8];
            { const int r32 = lane & 31, hh = lane >> 5;
#pragma unroll
                for (int st = 0; st < 8; ++st) { const size_t wo = ((size_t)(b * 32 + r32)) * 1024 + 128 * wave + 16 * st + 8 * hh; wh[st] = *(const pg8::bf16x8*)(WGH + wo); wl[st] = *(const pg8::bf16x8*)(WGL + wo); } }
            asm volatile("s_waitcnt vmcnt(0)" ::: "memory");
            LBAR();
            for (int grp = 0; grp < 4; ++grp) {
                const int m0 = rb * 128 + grp * 32;
                LAS unsigned char* T = TB + (grp & 1) * TBY;
                if (grp + 1 < 4) P8_DMA(grp + 1, (grp + 1) & 1);
                {
                    const int row = tid >> 4, cl = tid & 15; float ss = 0.f;
#pragma unroll
                    for (int i = 0; i < 8; ++i) { const v4u q = *(const LAS v4u*)(T + row * TP + (cl + 16 * i) * 16);
                        const float t0 = bflo(q.x), t1 = bfhi(q.x), t2 = bflo(q.y), t3 = bfhi(q.y), t4 = bflo(q.z), t5 = bfhi(q.z), t6 = bflo(q.w), t7 = bfhi(q.w);
                        ss += (t0 * t0 + t1 * t1) + (t2 * t2 + t3 * t3) + (t4 * t4 + t5 * t5) + (t6 * t6 + t7 * t7); }
                    ss += __shfl_xor(ss, 1); ss += __shfl_xor(ss, 2); ss += __shfl_xor(ss, 4); ss += __shfl_xor(ss, 8);
                    if (cl == 0) RS[row] = rsqrtf(ss * (1.f / D) + EPS);
                }
                LBAR();
                {
#pragma unroll
                    for (int i = 0; i < 8; ++i) { const int row = (lane >> 4) + 4 * i; const float rs = RS[row];
                        const v4u q = *(const LAS v4u*)(T + row * TP + (128 * wave + 8 * (lane & 15)) * 2);
                        v4u o; o.x = pkbf(bflo(q.x) * rs * gq[0] + sq[0], bfhi(q.x) * rs * gq[1] + sq[1]); o.y = pkbf(bflo(q.y) * rs * gq[2] + sq[2], bfhi(q.y) * rs * gq[3] + sq[3]);
                        o.z = pkbf(bflo(q.z) * rs * gq[4] + sq[4], bfhi(q.z) * rs * gq[5] + sq[5]); o.w = pkbf(bflo(q.w) * rs * gq[6] + sq[6], bfhi(q.w) * rs * gq[7] + sq[7]);
                        *(v4u*)(H + (size_t)(m0 + row) * D + 128 * wave + 8 * (lane & 15)) = o; }
                }
                f32x16 acc;
                {
#pragma unroll
                    for (int i = 0; i < 16; ++i) acc[i] = 0.f;
                    const int r32 = lane & 31, hh = lane >> 5;
#pragma unroll
                    for (int st = 0; st < 8; ++st) { const pg8::bf16x8 ah = *(const LAS pg8::bf16x8*)(T + r32 * TP + (128 * wave + 16 * st + 8 * hh) * 2);
                        acc = __builtin_amdgcn_mfma_f32_32x32x16_bf16(ah, wh[st], acc, 0, 0, 0); acc = __builtin_amdgcn_mfma_f32_32x32x16_bf16(ah, wl[st], acc, 0, 0, 0); }
                }
                LBAR();
                float* RED = (float*)(lds + (grp & 1) * TBY);
                { const int r32 = lane & 31, hh = lane >> 5;
#pragma unroll
                    for (int reg = 0; reg < 16; ++reg) RED[(wave * 32 + (reg & 3) + 8 * (reg >> 2) + 4 * hh) * 32 + r32] = acc[reg]; }
                LBAR();
#pragma unroll
                for (int j = 0; j < 2; ++j) {
                    const int row = 4 * wave + 2 * j + (lane >> 5), me = lane & 31, m = m0 + row;
                    float v = 0.f;
#pragma unroll
                    for (int w2 = 0; w2 < 8; ++w2) v += RED[(w2 * 32 + row) * 32 + me];
                    float val = v * RS[row] + CB[b * 32 + me];
                    float tv[4]; int ti[4];
#pragma unroll
                    for (int k2 = 0; k2 < 4; ++k2) { float mx = val;
#pragma unroll
                        for (int o = 1; o < 32; o <<= 1) mx = fmaxf(mx, __shfl_xor(mx, o));
                        int em = (val == mx) ? me : 99;
#pragma unroll
                        for (int o = 1; o < 32; o <<= 1) { const int w3 = __shfl_xor(em, o); em = w3 < em ? w3 : em; }
                        tv[k2] = mx; ti[k2] = em; if (me == em) val = -3.0e38f; }
                    const float e1 = __expf(tv[1] - tv[0]), e2 = __expf(tv[2] - tv[0]), e3 = __expf(tv[3] - tv[0]); const float inv = __builtin_amdgcn_rcpf(1.f + e1 + e2 + e3);
                    if (me < 4) { const int e = me == 0 ? ti[0] : me == 1 ? ti[1] : me == 2 ? ti[2] : ti[3]; const float w = (me == 0 ? 1.f : me == 1 ? e1 : me == 2 ? e2 : e3) * inv;
                        TOPI[(size_t)m * 4 + me] = e; TOPW[(size_t)m * 4 + me] = w;
                        const int lp = atomicAdd(&lcnt[e], 1); const int li = (grp * 32 + row) * 4 + me; lent[li * 3] = (e << 16) | lp; lent[li * 3 + 1] = m * 4 + me; lent[li * 3 + 2] = __builtin_bit_cast(int, w); }
                }
                asm volatile("s_waitcnt vmcnt(0)" ::: "memory");
                LBAR();
            }
            if (tid < 32) lbase[tid] = (int)atomicAdd(&CNT[tid], (unsigned)lcnt[tid]);
            __syncthreads();
            { const int w0 = lent[tid * 3], e = w0 >> 16, lp = w0 & 0xffff; const size_t li = (size_t)e * M + lbase[e] + lp; LIST[li] = lent[tid * 3 + 1]; ((int*)(ws + WS_LISTW))[li] = lent[tid * 3 + 2]; }
            __syncthreads();
        }
#undef P8_DMA
    }
    SEAM(8); }

    for (int rep_ = 0; rep_ < NREP(10); ++rep_) { if (IN(10)) {
        PHASE_PTRS
        int* ts = (int*)(lds + AUX_OFF);
        moe_tile_table(CNT, ts, tid);
        const long L1all = (long)ts[NE] * 8, L1full = (L1all / G) * G;
        SchedMoe S{(const char*)H, (const char*)(ws + WS_W1), ts, LIST, (const float*)(ws + WS_LISTW), ap->in[I_B1], 2048, ts[NE], 8, G, bid, (size_t)2048 * 1024 * 2, true, 0, L1full, false, nullptr, 0u, 0, 8};
        EpiMoe1 E{ACT};
        pg8::gemm_phase<EpiMoe1, SchedMoe, true, true, 2>((LAS unsigned char*)lds, D, S, E, tid, (LAS unsigned char*)lds + 131072);
        __syncthreads();
    }
    SEAM(10); }

    for (int rep_ = 0; rep_ < NREP(11); ++rep_) { if (IN(11)) {
        PHASE_PTRS
        int* ts = (int*)(lds + AUX_OFF);
        moe_tile_table(CNT, ts, tid);
        const long L1all = (long)ts[NE] * 8, L1full = (L1all / G) * G; const int nleft = (int)(L1all - L1full);
        if (bid < nleft) {
            SchedMoe S1{(const char*)H, (const char*)(ws + WS_W1), ts, LIST, (const float*)(ws + WS_LISTW), ap->in[I_B1], 2048, ts[NE], 8, G, bid, (size_t)2048 * 1024 * 2, true, L1full, L1all, false, nullptr, 0u, 0, 8};
            EpiMoe1 E1{ACT};
            pg8::gemm_phase<EpiMoe1, SchedMoe, true, true, 2>((LAS unsigned char*)lds, D, S1, E1, tid, (LAS unsigned char*)lds + 131072);
            asm volatile("s_waitcnt vmcnt(0)" ::: "memory");
            __syncthreads();
            if (tid == 0) { __builtin_amdgcn_fence(__ATOMIC_RELEASE, "agent"); asm volatile("s_waitcnt vmcnt(0)" ::: "memory"); __hip_atomic_fetch_add(ctl + CW_MOE, 1u, RLX_AGENT); }
        }
        SchedMoe S{(const char*)ACT, (const char*)(ws + WS_W2), ts, LIST, (const float*)(ws + WS_LISTW), ap->in[I_B2], 1024, ts[NE], 4, G, (bid - nleft + G) % G, (size_t)1024 * 1024 * 2, false,
                   0, (long)ts[NE] * 4, true, nleft > 0 ? ctl + CW_MOE : nullptr, (unsigned)nleft * (unsigned)(rep_ + 1), L1full, 8};
        EpiMoe2 E{Y};
        pg8::gemm_phase<EpiMoe2, SchedMoe, true, false, 3>((LAS unsigned char*)lds, FF, S, E, tid, (LAS unsigned char*)lds + 131072);
        __syncthreads();
    }
    SEAM(11); }

    for (int rep_ = 0; rep_ < NREP(12); ++rep_) { if (IN(12)) {
        PHASE_PTRS
        const float* nfin = ap->in[I_NFIN];
        for (int m = gw; m < M; m += NGW) {
            const int b = m >> 13; const float* md = MOD + b * 6144 + 5120;
            float v[16]; float ss = 0.f;
#pragma unroll
            for (int c = 0; c < 2; ++c) {
                float mo[8] = {0.f, 0.f, 0.f, 0.f, 0.f, 0.f, 0.f, 0.f};
#pragma unroll
                for (int k2 = 0; k2 < 4; ++k2) { const v4u y = *(const v4u*)(Y + ((size_t)m * 4 + k2) * D + c * 512 + lane * 8);
                    mo[0] += bflo(y.x); mo[1] += bfhi(y.x); mo[2] += bflo(y.y); mo[3] += bfhi(y.y); mo[4] += bflo(y.z); mo[5] += bfhi(y.z); mo[6] += bflo(y.w); mo[7] += bfhi(y.w); }
                const v4u xq = *(const v4u*)(X2 + (size_t)m * D + c * 512 + lane * 8); const f32x4 xa[2] = {(f32x4){bflo(xq.x), bfhi(xq.x), bflo(xq.y), bfhi(xq.y)}, (f32x4){bflo(xq.z), bfhi(xq.z), bflo(xq.w), bfhi(xq.w)}};
#pragma unroll
                for (int q = 0; q < 2; ++q) { const f32x4 xv = xa[q]; const f32x4 gv = *(const f32x4*)(md + c * 512 + lane * 8 + q * 4);
#pragma unroll
                    for (int j = 0; j < 4; ++j) { const float t = xv[j] + gv[j] * mo[q * 4 + j]; v[c * 8 + q * 4 + j] = t; ss += t * t; } }
            }
            const float rstd = rsqrtf(wave_sum(ss) * (1.f / D) + EPS);
#pragma unroll
            for (int c = 0; c < 2; ++c)
#pragma unroll
                for (int q = 0; q < 2; ++q) { const f32x4 nv = *(const f32x4*)(nfin + c * 512 + lane * 8 + q * 4);
                    *(f32x4*)(ap->out + (size_t)m * D + c * 512 + lane * 8 + q * 4) = (f32x4){v[c * 8 + q * 4] * rstd * nv[0], v[c * 8 + q * 4 + 1] * rstd * nv[1], v[c * 8 + q * 4 + 2] * rstd * nv[2], v[c * 8 + q * 4 + 3] * rstd * nv[3]}; }
        }
    }
    if (NREP(12) > 1) xcd_barrier(bar); }
#undef IN
#undef SEAM
}

extern "C" void kernel_launch(void* const* d_in, const int* in_sizes, int n_in, void* d_out, int out_size, void* d_ws, size_t ws_size, hipStream_t stream) {
    static int grid = 0;
    if (grid == 0) {
        if (n_in != 28 || in_sizes[0] != M * D || out_size != M * D || ws_size < WS_END) { fprintf(stderr, "kernel_launch: unexpected shapes/workspace (n_in %d, ws %zu)\n", n_in, ws_size); grid = -1; return; }
        int dev = 0, cus = 0;
        if (hipGetDevice(&dev) != hipSuccess || hipDeviceGetAttribute(&cus, hipDeviceAttributeMultiprocessorCount, dev) != hipSuccess) { grid = -1; return; }
        if (hipFuncSetAttribute((const void*)mk_fwd, hipFuncAttributeMaxDynamicSharedMemorySize, LDS_BYTES) != hipSuccess) { fprintf(stderr, "kernel_launch: hipFuncSetAttribute failed\n"); grid = -1; return; }
        int per_cu = 0;
        if (hipOccupancyMaxActiveBlocksPerMultiprocessor(&per_cu, (const void*)mk_fwd, NTHR, LDS_BYTES) != hipSuccess || per_cu < 1) fprintf(stderr, "kernel_launch: occupancy query reports %d\n", per_cu);
        (void)hipGetLastError();
        grid = cus;
    }
    if (grid < 0) return;
    if (hipMemsetAsync((char*)d_ws + WS_CTL, 0, CTL_ZERO_BYTES, stream) != hipSuccess) return;
    Args a{};
    for (int i = 0; i < 28; ++i) a.in[i] = (const float*)d_in[i];
    a.out = (float*)d_out; a.ws = (unsigned char*)d_ws;
    for (int li = 0; li < N_LAUNCHES; ++li) {
        a.ph_lo = (N_LAUNCHES == 1) ? 0 : li; a.ph_hi = (N_LAUNCHES == 1) ? NPH : li + 1; a.li = li; a.pad = 0;
        hipLaunchKernelGGL(mk_fwd, dim3(grid), dim3(NTHR), LDS_BYTES, stream, a);
        if (hipPeekAtLastError() != hipSuccess) { fprintf(stderr, "kernel_launch: launch %d failed\n", li); break; }
    }
}
```

```cpp
#include <hip/hip_runtime.h>
#include <cstdio>
#include <cstdint>

#ifndef PROBE_EPI
#define PROBE_EPI 0
#endif
#ifndef PROBE_SUB
#define PROBE_SUB 0
#endif
#ifndef MK_N_LAUNCHES
#define MK_N_LAUNCHES 1
#endif

namespace pg8 {
#define PG8_LAS __attribute__((address_space(3)))
typedef unsigned short bf16_t;
typedef short bf16x8 __attribute__((ext_vector_type(8)));
typedef float f32x4 __attribute__((ext_vector_type(4)));
typedef float f32x2 __attribute__((ext_vector_type(2)));
typedef unsigned u32x4 __attribute__((ext_vector_type(4)));
typedef unsigned u32x2 __attribute__((ext_vector_type(2)));
constexpr int BM = 256, BK = 64, HALF = 128, HTB = HALF * BK * 2, STAGE_BYTES = 8 * HTB, NXCD = 8, WGM = 4;

__host__ __device__ __forceinline__ int lds_byte(int r, int c) { const int st = (r >> 4) * 2 + (c >> 5), rr = r & 15, cc = c & 31, ob = rr * 64 + cc * 2; return st * 1024 + (ob ^ (((ob >> 9) & 1) << 5)); }
__host__ __device__ __forceinline__ void stage_rc(int b, int& R, int& C) { const int st = b / 1024, sb = b % 1024, swz = sb ^ (((sb >> 9) & 1) << 5); R = (st >> 1) * 16 + swz / 64; C = (st & 1) * 32 + (swz % 64) / 2; }
__host__ __device__ __forceinline__ int perm32(int rho) { const int n = rho >> 4, i = rho & 15; return 8 * (i >> 2) + 4 * n + (i & 3); }

struct Unit { int pm, pn, aux, nvalid; const char* A; const char* B; const void* tp[3]; };

__device__ __forceinline__ bool tile_map(long L, int nM, int nN, int& pm, int& pn) {
    const int nwg = nM * nN; if (L >= nwg) return false;
    int wgid = (int)L; { const int q = nwg / NXCD, r = nwg % NXCD, xcd = wgid % NXCD, off = wgid / NXCD; wgid = (xcd < r ? xcd * (q + 1) : r * (q + 1) + (xcd - r) * q) + off; }
    const int nig = WGM * nN, gid = wgid / nig, fm = gid * WGM, gsz = (nM - fm) < WGM ? (nM - fm) : WGM;
    pm = fm + ((wgid % nig) % gsz); pn = (wgid % nig) / gsz; return true;
}
__device__ __forceinline__ const char* uptr(const char* p) {
    unsigned long long v = (unsigned long long)p; unsigned lo = __builtin_amdgcn_readfirstlane((unsigned)v), hi = __builtin_amdgcn_readfirstlane((unsigned)(v >> 32));
    return (const char*)(((unsigned long long)hi << 32) | lo);
}
__device__ __forceinline__ unsigned cvt_pk_bf16(float lo, float hi) { unsigned r; asm volatile("v_cvt_pk_bf16_f32 %0, %1, %2" : "=v"(r) : "v"(lo), "v"(hi)); return r; }
__device__ __forceinline__ float bf_lo(unsigned w) { return __builtin_bit_cast(float, w << 16); }
__device__ __forceinline__ float bf_hi(unsigned w) { return __builtin_bit_cast(float, w & 0xffff0000u); }

template <class Epi, class Sched, bool ALIGN_EPI = false, bool GATHER = false, int NTAB = 0>
__device__ __forceinline__ void gemm_phase(PG8_LAS unsigned char* lds, const int K, const Sched& S, const Epi& E, const int tid, PG8_LAS unsigned char* tabs = nullptr) {
    const int wid = __builtin_amdgcn_readfirstlane(tid >> 6), lane = tid & 63, wr = wid >> 2, wc = wid & 3, fr = lane & 15, fq = lane >> 4;
    const int nt = K / BK;
    unsigned voffA[2], voffB[2]; int RlA[2]; unsigned ClA[2];
#pragma unroll
    for (int i = 0; i < 2; ++i) { int R, C; stage_rc(tid * 16 + i * 8192, R, C); const int Rb = Epi::PERM ? ((R & ~31) + perm32(R & 31)) : R;
        voffA[i] = (unsigned)(R * K + C) * 2u; voffB[i] = (unsigned)(Rb * K + C) * 2u; RlA[i] = R; ClA[i] = (unsigned)C * 2u; }
    const size_t kstep = (size_t)(BK * 2);
    const size_t hstep = (size_t)HALF * K * 2;
    const unsigned ldsw = (unsigned)wid * 1024u;
    const int aoff = lds_byte(wr * 64 + fr, fq * 8), boff = lds_byte(wc * 32 + fr, fq * 8);
#define PG8_SA(b, h) (((b) * 2 + (h)) * HTB)
#define PG8_SB(b, h) ((4 + (b) * 2 + (h)) * HTB)
#define PG8_STAGE(bufoff, gbase, voff) do { _Pragma("unroll") for (int _i = 0; _i < 2; ++_i) \
        __builtin_amdgcn_global_load_lds((const unsigned*)((const char*)(gbase) + (voff)[_i]), (PG8_LAS unsigned*)(lds + (bufoff) + ldsw + _i * 8192), 16, 0, 0); } while (0)
#define PG8_STA(bufoff, p, h, vg) do { if constexpr (GATHER) PG8_STAGE(bufoff, p, (vg)[h]); else PG8_STAGE(bufoff, (p) + (h) * hstep, voffA); } while (0)
#define PG8_LDA(dst, b, h) do { _Pragma("unroll") for (int m = 0; m < 4; ++m) _Pragma("unroll") for (int k = 0; k < 2; ++k) dst[m][k] = *(const PG8_LAS bf16x8*)(lds + PG8_SA(b, h) + aoff + m * 2048 + k * 1024); } while (0)
#define PG8_LDB(dst, b, h) do { _Pragma("unroll") for (int n = 0; n < 2; ++n) _Pragma("unroll") for (int k = 0; k < 2; ++k) dst[n][k] = *(const PG8_LAS bf16x8*)(lds + PG8_SB(b, h) + boff + n * 2048 + k * 1024); } while (0)
#define PG8_MMA(ai, bj, At, Bt) do { __builtin_amdgcn_s_setprio(1); _Pragma("unroll") for (int m = 0; m < 4; ++m) _Pragma("unroll") for (int n = 0; n < 2; ++n) _Pragma("unroll") for (int k = 0; k < 2; ++k) \
        acc[ai][bj][m][n] = __builtin_amdgcn_mfma_f32_16x16x32_bf16(Bt[n][k], At[m][k], acc[ai][bj][m][n], 0, 0, 0); __builtin_amdgcn_s_setprio(0); } while (0)
#define PG8_WAIT_V(n) asm volatile("s_waitcnt vmcnt(" #n ")" ::: "memory")
#define PG8_WAIT_L(n) asm volatile("s_waitcnt lgkmcnt(" #n ")" ::: "memory")
#define PG8_BAR __builtin_amdgcn_s_barrier()
#define PG8_SCHED __builtin_amdgcn_sched_barrier(0)
#define PG8_TAB_DMA(u_, ui_) do { if (wid < NTAB) __builtin_amdgcn_global_load_lds((const unsigned*)((const char*)(wid == 0 ? (u_).tp[0] : wid == 1 ? (u_).tp[1] : (u_).tp[2]) + lane * 16), (PG8_LAS unsigned*)(tabs + ((ui_) % 3) * 3072 + wid * 1024), 16, 0, 0); } while (0)
#define PG8_IDS_READ(u_, ui_, vg) do { const PG8_LAS int* ids = (const PG8_LAS int*)(tabs + ((ui_) % 3) * 3072); _Pragma("unroll") for (int _h = 0; _h < 2; ++_h) _Pragma("unroll") for (int _i = 0; _i < 2; ++_i) { const int _row = _h * HALF + RlA[_i]; const int _id = ids[_row]; \
        const unsigned _tok = _row < (u_).nvalid ? (unsigned)(_id >> 2) : 0u; (vg)[_h][_i] = _tok * (unsigned)(K * 2) + ClA[_i]; } } while (0)
    Unit cur, nxt; int ui = 0;
    if (!S.next(0, cur)) return;
    unsigned vG[2][2] = {{0u, 0u}, {0u, 0u}}, vGn[2][2] = {{0u, 0u}, {0u, 0u}};
    if constexpr (NTAB > 0) { PG8_TAB_DMA(cur, 0); PG8_WAIT_V(0); PG8_BAR; asm volatile("" ::: "memory"); }
    if constexpr (GATHER) { PG8_IDS_READ(cur, 0, vG); PG8_WAIT_L(0); PG8_BAR; }
    f32x4 acc[2][2][4][2];
#define PG8_ACC_INIT(ui_) do { \
    if constexpr (Epi::BIAS_INIT) { f32x4 bv_[2][2]; const PG8_LAS float* bp_ = (const PG8_LAS float*)(tabs + ((ui_) % 3) * 3072 + 1024) + wc * 32 + 8 * fq;   \
        _Pragma("unroll") for (int b = 0; b < 2; ++b) _Pragma("unroll") for (int n = 0; n < 2; ++n) bv_[b][n] = *(const PG8_LAS f32x4*)(bp_ + b * 128 + 4 * n); \
        _Pragma("unroll") for (int a = 0; a < 2; ++a) _Pragma("unroll") for (int b = 0; b < 2; ++b) _Pragma("unroll") for (int m = 0; m < 4; ++m) _Pragma("unroll") for (int n = 0; n < 2; ++n) acc[a][b][m][n] = bv_[b][n]; } \
    else { _Pragma("unroll") for (int a = 0; a < 2; ++a) _Pragma("unroll") for (int b = 0; b < 2; ++b) _Pragma("unroll") for (int m = 0; m < 4; ++m) _Pragma("unroll") for (int n = 0; n < 2; ++n) acc[a][b][m][n] = (f32x4){0.f, 0.f, 0.f, 0.f}; } } while (0)
    PG8_ACC_INIT(0);
    bf16x8 At[4][2], B0[2][2], B1[2][2];
    const char* cA = cur.A; const char* cB = cur.B;
    PG8_STAGE(PG8_SB(0, 0), cB, voffB); PG8_STAGE(PG8_SB(0, 1), cB + hstep, voffB); PG8_STA(PG8_SA(0, 0), cA, 0, vG); PG8_STA(PG8_SA(0, 1), cA, 1, vG);
    if (wr == 1) PG8_BAR;
    PG8_WAIT_V(2); PG8_BAR;
    PG8_STAGE(PG8_SB(1, 0), cB + kstep, voffB); PG8_STA(PG8_SA(1, 0), cA + kstep, 0, vG); PG8_STAGE(PG8_SB(1, 1), cB + hstep + kstep, voffB);
    PG8_WAIT_V(6); PG8_BAR;
    for (;;) {
        const bool has_next = S.next(ui + 1, nxt);
        const char* nA = has_next ? nxt.A : cA; const char* nB = has_next ? nxt.B : cB;
        if constexpr (NTAB > 0) { if (has_next) PG8_TAB_DMA(nxt, ui + 1); }
#define PG8_TRIP() do { \
            const bool last = (t == nt - 2); \
            const char* a1 = cA + (size_t)(t + 1) * kstep; \
            const char* a2 = last ? nA : cA + (size_t)(t + 2) * kstep; const char* b2 = last ? nB : cB + (size_t)(t + 2) * kstep; \
            const char* a3 = a2 + kstep; const char* b3 = b2 + kstep; \
            unsigned vS[2][2]; \
            if constexpr (GATHER) { if (last && has_next) PG8_IDS_READ(nxt, ui + 1, vGn); \
                _Pragma("unroll") \
                for (int h = 0; h < 2; ++h) \
                _Pragma("unroll") \
                    for (int i = 0; i < 2; ++i) vS[h][i] = (last && has_next) ? vGn[h][i] : vG[h][i]; } \
            PG8_LDB(B0, 0, 0); PG8_LDB(B1, 0, 1); PG8_SCHED; PG8_LDA(At, 0, 0); PG8_STA(PG8_SA(1, 1), a1, 1, vG); \
            PG8_WAIT_V(8); PG8_WAIT_L(0); PG8_BAR; PG8_MMA(0, 0, At, B0); PG8_MMA(0, 1, At, B1); PG8_BAR; PG8_SCHED; \
            PG8_LDA(At, 0, 1); PG8_STAGE(PG8_SB(0, 0), b2, voffB); PG8_STAGE(PG8_SB(0, 1), b2 + hstep, voffB); PG8_STA(PG8_SA(0, 0), a2, 0, vS); \
            PG8_WAIT_V(8); PG8_WAIT_L(0); PG8_BAR; PG8_MMA(1, 0, At, B0); PG8_MMA(1, 1, At, B1); PG8_BAR; PG8_SCHED; \
            PG8_LDB(B0, 1, 0); PG8_LDB(B1, 1, 1); PG8_SCHED; PG8_LDA(At, 1, 0); PG8_STA(PG8_SA(0, 1), a2, 1, vS); \
            PG8_WAIT_V(8); PG8_WAIT_L(0); PG8_BAR; PG8_MMA(0, 0, At, B0); PG8_MMA(0, 1, At, B1); PG8_BAR; PG8_SCHED; \
            PG8_LDA(At, 1, 1); PG8_STAGE(PG8_SB(1, 0), b3, voffB); PG8_STAGE(PG8_SB(1, 1), b3 + hstep, voffB); PG8_STA(PG8_SA(1, 0), a3, 0, vS); \
            PG8_WAIT_V(8); PG8_WAIT_L(0); PG8_BAR; PG8_MMA(1, 0, At, B0); PG8_MMA(1, 1, At, B1); PG8_BAR; PG8_SCHED; \
        } while (0)
        if constexpr (Epi::MIDK) {
            for (int t = 0; t < nt / 2; t += 2) PG8_TRIP();
            PG8_SCHED; E.mid(acc, cur, wr, wc, fr, fq); PG8_SCHED;
            for (int t = nt / 2; t < nt; t += 2) PG8_TRIP();
        } else {
            for (int t = 0; t < nt; t += 2) PG8_TRIP();
        }
#undef PG8_TRIP
        if constexpr (ALIGN_EPI) { if (wr == 0) PG8_BAR; }
        E(acc, cur, wr, wc, fr, fq, tabs + (ui % 3) * 3072);
        if constexpr (Epi::PROBE2X) { E(acc, cur, wr, wc, fr, fq, tabs + (ui % 3) * 3072); }
        if (!has_next) break;
        PG8_ACC_INIT(ui + 1);
        cur = nxt; cA = nA; cB = nB; ++ui;
        if constexpr (GATHER) {
#pragma unroll
            for (int h = 0; h < 2; ++h)
#pragma unroll
                for (int i = 0; i < 2; ++i) vG[h][i] = vGn[h][i]; }
        if constexpr (ALIGN_EPI) { if (wr == 1) PG8_BAR; }
    }
    PG8_WAIT_V(0);
    if constexpr (!ALIGN_EPI) { if (wr == 0) PG8_BAR; }
    PG8_BAR;
#undef PG8_SA
#undef PG8_SB
#undef PG8_STAGE
#undef PG8_STA
#undef PG8_LDA
#undef PG8_LDB
#undef PG8_MMA
#undef PG8_WAIT_V
#undef PG8_WAIT_L
#undef PG8_BAR
#undef PG8_SCHED
#undef PG8_TAB_DMA
#undef PG8_IDS_READ
#undef PG8_ACC_INIT
}
}

constexpr int NWAVES = 8, NTHR = 512;
constexpr int NPH = 13;
constexpr int N_LAUNCHES = MK_N_LAUNCHES;
constexpr int D = 1024, BATCH = 4, SEQ = 8192, M = BATCH * SEQ;
constexpr int DIN = 5128, NPROJ = 5120;
constexpr int C_Q = 0, C_K = 512, C_V = 1024, C_Z = 1536, C_XB = 2048, C_YB = 2560, C_GT = 3072;
constexpr int NE = 32, TOPK = 4, FF = 1024, NASG = M * TOPK;
constexpr int LCH = 128, NLCH = SEQ / LCH;
constexpr float EPS = 1e-6f;
constexpr int NSPLIT = 16;

constexpr size_t MiB = 1u << 20;
constexpr size_t WS_CTL = 0, CTL_ZERO_BYTES = 1 * MiB;
constexpr size_t WS_MOD = 1 * MiB;
constexpr size_t WS_BA = 2 * MiB;
constexpr size_t WS_BG = 3 * MiB;
constexpr size_t WS_LEND = 4 * MiB;
constexpr size_t WS_TOPI = 5 * MiB;
constexpr size_t WS_TOPW = 5 * MiB + 512 * 1024;
constexpr size_t WS_LIST = 6 * MiB;
constexpr size_t WS_WGH = 10 * MiB;
constexpr size_t WS_WGL = 11 * MiB;
constexpr size_t WS_CB = 12 * MiB;
constexpr size_t WS_WIN = 16 * MiB;
constexpr size_t WS_WBG = 26 * MiB, WS_WBL = 27 * MiB;
constexpr size_t WS_WOUT = 28 * MiB;
constexpr size_t WS_W1 = 32 * MiB;
constexpr size_t WS_W2 = 160 * MiB;
constexpr size_t WS_H = 224 * MiB;
constexpr size_t WS_X2 = 288 * MiB;
constexpr size_t WS_HLOC = 288 * MiB, WS_PLOC = 320 * MiB, WS_OCAT = 352 * MiB;
constexpr size_t WS_LISTW = 352 * MiB;
constexpr size_t WS_MERGED = 416 * MiB;
constexpr size_t WS_PROJ = 480 * MiB;
constexpr size_t WS_GBLOB = 800 * MiB;
constexpr size_t WS_GU = 912 * MiB;
constexpr size_t WS_GL = 944 * MiB;
constexpr size_t WS_OGDN = 992 * MiB;
constexpr size_t WS_XS = 480 * MiB;
constexpr size_t WS_ACT = 752 * MiB;
constexpr size_t WS_Y = 480 * MiB;
constexpr size_t WS_END = 1024 * MiB;
constexpr int MAXSLOT = NASG + NE * 256;
constexpr int CW_TMO = 0;
constexpr int CW_CNT = 1024;
constexpr int CW_LRU = 2048;
constexpr int CW_P3 = 2184;
constexpr int CW_SCAN = 2188;
constexpr int CW_MOE = 2176;
constexpr int CW_GDN2 = 2112;
constexpr int SG0 = 16, SGC = 32, NSTG = 1 + (128 - 16 - SG0 + SGC - 1) / SGC;
__device__ __forceinline__ int gdn_stage_of(int c) { return c < SG0 ? 0 : 1 + (c - SG0) / SGC; }
constexpr int CW_BAR = 4096;
constexpr int RING_BYTES = 155648;
constexpr int LDSCTL_OFF = RING_BYTES, MISC_OFF = LDSCTL_OFF + 320;
constexpr int AUX_OFF = RING_BYTES + 1024;
constexpr int LDS_BYTES = 163840;

#define GAS __attribute__((address_space(1)))
#define LAS __attribute__((address_space(3)))
typedef unsigned short bf16;
typedef unsigned v4u __attribute__((ext_vector_type(4)));
typedef unsigned v2u __attribute__((ext_vector_type(2)));
typedef float f32x4 __attribute__((ext_vector_type(4)));
typedef float f32x2 __attribute__((ext_vector_type(2)));
typedef float f32x16 __attribute__((ext_vector_type(16)));
typedef __bf16 b16x2_t __attribute__((ext_vector_type(2)));
__device__ __forceinline__ unsigned pkbf(float a, float b) { f32x2 v = {a, b}; b16x2_t r = __builtin_convertvector(v, b16x2_t); return __builtin_bit_cast(unsigned, r); }
__device__ __forceinline__ unsigned f2bf(float f) { return pkbf(f, 0.f) & 0xffffu; }
__device__ __forceinline__ unsigned pk2(float lo, float hi) { return pkbf(lo, hi); }
#define RLX_AGENT __ATOMIC_RELAXED, __HIP_MEMORY_SCOPE_AGENT
#define LDS_WAIT() asm volatile("s_waitcnt lgkmcnt(0)" ::: "memory")
#define LBAR() do { asm volatile("s_waitcnt lgkmcnt(0)" ::: "memory"); __builtin_amdgcn_s_barrier(); asm volatile("" ::: "memory"); } while (0)
__device__ __forceinline__ float bflo(unsigned w) { return __builtin_bit_cast(float, w << 16); }
__device__ __forceinline__ float bfhi(unsigned w) { return __builtin_bit_cast(float, w & 0xffff0000u); }
__device__ __forceinline__ float bf1(bf16 h) { return __builtin_bit_cast(float, (unsigned)h << 16); }
__device__ __forceinline__ float sigmoidf_(float v) { return __builtin_amdgcn_rcpf(1.f + __expf(-v)); }
__device__ __forceinline__ float siluf_(float v) { return v * __builtin_amdgcn_rcpf(1.f + __expf(-v)); }
__device__ __forceinline__ float gelu_tanh_(float x) { const float u2 = 1.5957691216057308f * (x + 0.044715f * x * x * x); return x * __builtin_amdgcn_rcpf(1.f + __expf(-u2)); }
__device__ __forceinline__ float softplusf_(float v) { return v > 20.f ? v : log1pf(__expf(v)); }
__device__ __forceinline__ float wave_sum(float v) {
#pragma unroll
    for (int o = 1; o < 64; o <<= 1) v += __shfl_xor(v, o);
    return v;
}
__device__ __forceinline__ float wave_max(float v) {
#pragma unroll
    for (int o = 1; o < 64; o <<= 1) v = fmaxf(v, __shfl_xor(v, o));
    return v;
}
__device__ __forceinline__ int wave_min_i(int v) {
#pragma unroll
    for (int o = 1; o < 64; o <<= 1) { int w = __shfl_xor(v, o); v = w < v ? w : v; }
    return v;
}

#define XB_TMO      128
#define XB_XCNT(j)  (256  + 64 * (j))
#define XB_XSUB(j)  (1280 + 64 * (j))
#define XB_XGEN(j)  (2304 + 64 * (j))
#define XB_TOP      3328
#define XB_TOPGEN   3392
#define XCD_BAR_WORDS 3456
#define XB_SPIN_CAP (1u << 22)
__device__ __forceinline__ unsigned xb_ld(unsigned* p)              { return __hip_atomic_load(p, __ATOMIC_RELAXED, __HIP_MEMORY_SCOPE_AGENT); }
__device__ __forceinline__ unsigned xb_add(unsigned* p, unsigned v) { return __hip_atomic_fetch_add(p, v, __ATOMIC_RELAXED, __HIP_MEMORY_SCOPE_AGENT); }
__device__ __forceinline__ unsigned xb_xcc_id() { return (unsigned)__builtin_amdgcn_s_getreg((3 << 11) | 20) & 0xFu; }
#define XB_SPIN(cond, bar) do { unsigned _sp = 0; while (cond) { __builtin_amdgcn_s_sleep(1); \
    if ((++_sp & 255u) == 0u) { if (xb_ld(&(bar)[XB_TMO])) break; if (_sp > XB_SPIN_CAP) { atomicAdd(&(bar)[XB_TMO], 1u); break; } } } } while (0)
struct XcdBarrier { unsigned* bar; unsigned x; volatile LAS unsigned* st; };
__device__ __forceinline__ XcdBarrier xcd_barrier_post(unsigned* bar, volatile LAS unsigned* st) {
    XcdBarrier b; b.bar = bar; b.x = xb_xcc_id(); b.st = st;
    if (threadIdx.x == 0) (void)xb_add(&bar[XB_XCNT(b.x)], 1u);
    return b;
}
__device__ __forceinline__ void xcd_barrier_complete(unsigned* bar, unsigned x, unsigned& nloc, unsigned& nx) {
    const unsigned G = gridDim.x * gridDim.y * gridDim.z;
    unsigned sum, cnt, mine, sp = 0u;
    for (;;) {
        sum = 0u; cnt = 0u; mine = 0u;
#pragma unroll
        for (unsigned j = 0; j < 16; ++j) { const unsigned c = xb_ld(&bar[XB_XCNT(j)]); sum += c; cnt += (c > 0u) ? 1u : 0u; mine = (j == x) ? c : mine; }
        if (sum == G) break;
        __builtin_amdgcn_s_sleep(1);
        if ((++sp & 255u) == 0u) { if (xb_ld(&bar[XB_TMO])) break; if (sp > XB_SPIN_CAP) { atomicAdd(&bar[XB_TMO], 1u); break; } }
    }
    nloc = mine > 0u ? mine : 1u; nx = cnt > 0u ? cnt : 1u;
}
__device__ __forceinline__ void xcd_barrier(const XcdBarrier& b) {
    asm volatile("s_waitcnt vmcnt(0)" ::: "memory");
    __syncthreads();
    if (threadIdx.x == 0) {
        unsigned* bar = b.bar;
        __builtin_amdgcn_s_waitcnt(0);
        unsigned nloc = b.st[0], nx = b.st[1];
        if (nloc == 0u) { xcd_barrier_complete(bar, b.x, nloc, nx); b.st[0] = nloc; b.st[1] = nx; }
        const unsigned old = xb_add(&bar[XB_XSUB(b.x)], 1u);
        const unsigned gen = old / nloc;
        if (old + 1u == (gen + 1u) * nloc) {
            __builtin_amdgcn_fence(__ATOMIC_RELEASE, "agent");
            asm volatile("s_waitcnt vmcnt(0)" ::: "memory");
            const unsigned og = xb_add(&bar[XB_TOP], 1u);
            const unsigned tg = og / nx;
            if (og + 1u == (tg + 1u) * nx) xb_add(&bar[XB_TOPGEN], 1u);
            else XB_SPIN(xb_ld(&bar[XB_TOPGEN]) == tg, bar);
            __builtin_amdgcn_fence(__ATOMIC_ACQUIRE, "agent");
            xb_add(&bar[XB_XGEN(b.x)], 1u);
            asm volatile("s_waitcnt vmcnt(0)" ::: "memory");
        } else {
            XB_SPIN(xb_ld(&bar[XB_XGEN(b.x)]) == gen, bar);
            __builtin_amdgcn_fence(__ATOMIC_ACQUIRE, "agent");
            asm volatile("s_waitcnt vmcnt(0)" ::: "memory");
        }
    }
    __syncthreads();
}

struct Args { const float* in[28]; float* out; unsigned char* ws; int ph_lo, ph_hi, li, pad; };
enum { I_X = 0, I_C, I_WADA, I_BADA, I_NMIX, I_NFFN, I_WIN, I_GCONV, I_GALOG, I_GDT, I_GNORM, I_LCONVW, I_LCONVB, I_LWA, I_LBA, I_LWX, I_LBX, I_LLAM,
       I_WBG, I_WBL, I_WOUT, I_WR, I_BR, I_W1, I_B1, I_W2, I_B2, I_NFIN };

struct TrItem { const float* W; bf16* WT; int ld, K, k0, n0; };
__device__ __forceinline__ void p0_tr_load(const TrItem& t, float (&v)[32], int lane) {
#pragma unroll
    for (int i = 0; i < 32; ++i) { const int kk = 2 * i + (lane >> 5); v[i] = t.W[(size_t)(t.k0 + kk) * t.ld + t.n0 + (lane & 31)]; }
}
__device__ __forceinline__ void p0_tr_finish(const TrItem& t, const float (&v)[32], float* scr, int lane) {
#pragma unroll
    for (int i = 0; i < 32; ++i) { const int kk = 2 * i + (lane >> 5); scr[kk * 33 + (lane & 31)] = v[i]; }
    LDS_WAIT(); asm volatile("" ::: "memory");
    const int c = lane & 7;
#pragma unroll
    for (int j = 0; j < 4; ++j) { const int n = (lane >> 3) + 8 * j; const float* s = scr + (8 * c) * 33 + n;
        v4u o; o.x = pkbf(s[0 * 33], s[1 * 33]); o.y = pkbf(s[2 * 33], s[3 * 33]); o.z = pkbf(s[4 * 33], s[5 * 33]); o.w = pkbf(s[6 * 33], s[7 * 33]);
        *(v4u*)(t.WT + (size_t)(t.n0 + n) * t.K + t.k0 + 8 * c) = o; }
    LDS_WAIT(); asm volatile("" ::: "memory");
}
__device__ __forceinline__ void p0_transpose_item(const float* W, int ld, int K, int nblk, bf16* WT, float* scr, int item, int lane) {
    TrItem t{W, WT, ld, K, 64 * (item / nblk), 32 * (item % nblk)}; float v[32]; p0_tr_load(t, v, lane); p0_tr_finish(t, v, scr, lane);
}

typedef short s16x4_t __attribute__((ext_vector_type(4)));
__device__ __forceinline__ void tr64_load(const TrItem& t, f32x4 (&v)[16], int lane) {
    const float* p = t.W + (size_t)(t.k0 + (lane >> 4)) * t.ld + t.n0 + 4 * (lane & 15);
#pragma unroll
    for (int i = 0; i < 16; ++i) v[i] = *(const f32x4*)(p + (size_t)(4 * i) * t.ld);
}
__device__ __forceinline__ void tr64_finish(const TrItem& t, const f32x4 (&v)[16], LAS unsigned char* T, int lane) {
    {
        const int q = lane >> 4, g4 = lane & 15;
#pragma unroll
        for (int i = 0; i < 16; ++i) *(LAS f32x4*)(T + (4 * i + q) * 256 + ((g4 ^ (i & 14)) << 4)) = v[i];
    }
    LDS_WAIT(); asm volatile("" ::: "memory");
    const int r = lane >> 3, c = lane & 7;
    const __amdgpu_buffer_rsrc_t rw_ = __builtin_amdgcn_make_buffer_rsrc((void*)pg8::uptr((const char*)t.WT), 0, 0x7fffffff, 0x00020000);
    const unsigned oo_ = (unsigned)(((t.n0 + r) * t.K + t.k0 + 8 * c) * 2);
#pragma unroll
    for (int j2 = 0; j2 < 8; ++j2) {
        const int n = 8 * j2 + r;
        LAS const float* rp = (LAS const float*)(T + (8 * c) * 256 + ((((n >> 2) ^ (2 * c)) & 15) << 4) + ((n & 3) << 2));
        float f[8];
#pragma unroll
        for (int j = 0; j < 8; ++j) f[j] = rp[j * 64];
        __builtin_amdgcn_raw_buffer_store_b128(((v4u){pkbf(f[0], f[1]), pkbf(f[2], f[3]), pkbf(f[4], f[5]), pkbf(f[6], f[7])}), rw_, oo_ + (unsigned)(8 * j2 * t.K * 2), 0,   16);
    }
    LDS_WAIT(); asm volatile("" ::: "memory");
}

struct SchedDense {
    const char* A; const char* B; int nM, nN, G, c, K;
    __device__ __forceinline__ bool next(int i, pg8::Unit& u) const {
        if (!pg8::tile_map((long)i * G + c, nM, nN, u.pm, u.pn)) return false;
        u.aux = 0; u.nvalid = 256; u.tp[0] = u.tp[1] = u.tp[2] = nullptr; u.A = pg8::uptr(A + (size_t)u.pm * 256 * K * 2); u.B = pg8::uptr(B + (size_t)u.pn * 256 * K * 2); return true;
    }
};
struct SchedBranch {
    const char *A0, *A1, *B0, *B1; int nM, nN, G, c;
    __device__ __forceinline__ bool next(int i, pg8::Unit& u) const {
        if (!pg8::tile_map((long)(i >> 1) * G + c, nM, nN, u.pm, u.pn)) return false;
        const int g = i & 1; u.aux = g; u.nvalid = 256; u.tp[0] = u.tp[1] = u.tp[2] = nullptr;
        u.A = pg8::uptr((g ? A1 : A0) + (size_t)u.pm * 256 * 512 * 2); u.B = pg8::uptr((g ? B1 : B0) + (size_t)u.pn * 256 * 512 * 2); return true;
    }
};
struct SchedMoe {
    const char* A; const char* W; const int* ts; const int* list; const float* listw; const float* bias; int bias_ld; int T, nN, G, c; size_t wexp; bool gatherA;
    long L0, Lend; bool rot; const unsigned* dep_ctr; unsigned dep_want; long dep_L; int dep_nN;
    __device__ __forceinline__ static long lin_of(int pm, int pn, int nM, int nN) {
        const int nwg = nM * nN, nig = pg8::WGM * nN, gid = pm / pg8::WGM, fm = gid * pg8::WGM, gsz = (nM - fm) < pg8::WGM ? (nM - fm) : pg8::WGM;
        const int wg = gid * nig + pn * gsz + (pm - fm); const int q = nwg / pg8::NXCD, r = nwg % pg8::NXCD;
        int xcd, off; if (wg < r * (q + 1)) { xcd = wg / (q + 1); off = wg - xcd * (q + 1); } else { const int w2 = wg - r * (q + 1); xcd = r + w2 / q; off = w2 - (xcd - r) * q; }
        return (long)off * pg8::NXCD + xcd;
    }
    __device__ __forceinline__ bool next(int i, pg8::Unit& u) const {
        int r = i;
        if (rot) { const long span = Lend - L0 - c; const int R = span > 0 ? (int)((span + G - 1) / G) : 0; if (i >= R) return false; r = (i + 1 < R) ? i + 1 : 0; }
        const long L = L0 + (long)r * G + c;
        if (L >= Lend || !pg8::tile_map(L, T, nN, u.pm, u.pn)) return false;
        int e = 0;
        for (int j = 1; j < NE; ++j) e += (ts[j] <= u.pm) ? 1 : 0;
        e = __builtin_amdgcn_readfirstlane(e);
        const int p0 = (u.pm - ts[e]) * 256, rem = ts[40 + e] - p0;
        u.aux = e; u.nvalid = __builtin_amdgcn_readfirstlane(rem < 256 ? rem : 256);
        u.tp[0] = (const void*)pg8::uptr((const char*)(list + (size_t)e * M + p0)); u.tp[1] = (const void*)pg8::uptr((const char*)(bias + (size_t)e * bias_ld + u.pn * 256)); u.tp[2] = (const void*)pg8::uptr((const char*)(listw + (size_t)e * M + p0));
        u.A = gatherA ? pg8::uptr(A) : pg8::uptr(A + (size_t)u.pm * 256 * 1024 * 2); u.B = pg8::uptr(W + (size_t)e * wexp + (size_t)u.pn * 256 * 1024 * 2);
        if (dep_ctr) {
            bool dep = false;
            for (int pn1 = 0; pn1 < dep_nN; ++pn1) dep = dep || (lin_of(u.pm, pn1, T, dep_nN) >= dep_L);
            if (__builtin_amdgcn_readfirstlane(dep ? 1 : 0)) { unsigned sp = 0;
                while (__hip_atomic_load(dep_ctr, __ATOMIC_RELAXED, __HIP_MEMORY_SCOPE_AGENT) < dep_want) { __builtin_amdgcn_s_sleep(2); if (++sp > (1u << 22)) break; }
                __builtin_amdgcn_fence(__ATOMIC_ACQUIRE, "agent"); }
        }
        return true;
    }
};

struct EpiProj { static constexpr bool BIAS_INIT = false; static constexpr bool MIDK = false; static constexpr bool PROBE2X = (PROBE_EPI & 1) != 0;
    static constexpr bool PERM = true;
    bf16* O;
    __device__ __forceinline__ void operator()(const pg8::f32x4 (&acc)[2][2][4][2], const pg8::Unit& u, int wr, int wc, int fr, int fq, const PG8_LAS unsigned char* tab) const {
        const int row0 = u.pm * 256 + wr * 64 + fr, col0 = u.pn * 256 + wc * 32 + 8 * fq; const bool sig = u.pn >= 12;
#pragma unroll
        for (int ai = 0; ai < 2; ++ai)
#pragma unroll
            for (int m = 0; m < 4; ++m) { bf16* rowp = O + (size_t)(row0 + ai * 128 + m * 16) * NPROJ + col0;
                pg8::f32x4 g0 = acc[ai][0][m][0], g1 = acc[ai][0][m][1], l0 = acc[ai][1][m][0], l1 = acc[ai][1][m][1];
                if (sig) {
#pragma unroll
                    for (int j = 0; j < 4; ++j) {
                        const float eg0 = __expf(-g0[j]), el0 = __expf(-l0[j]), eg1 = __expf(-g1[j]), el1 = __expf(-l1[j]);
                        g0[j] = fminf(1.f + el0, 1e6f) * __builtin_amdgcn_rcpf(1.f + eg0); l0[j] = fmaxf(__builtin_amdgcn_rcpf(1.f + el0), 1e-6f);
                        g1[j] = fminf(1.f + el1, 1e6f) * __builtin_amdgcn_rcpf(1.f + eg1); l1[j] = fmaxf(__builtin_amdgcn_rcpf(1.f + el1), 1e-6f); } }
                { v4u w; w.x = pg8::cvt_pk_bf16(g0[0], g0[1]); w.y = pg8::cvt_pk_bf16(g0[2], g0[3]); w.z = pg8::cvt_pk_bf16(g1[0], g1[1]); w.w = pg8::cvt_pk_bf16(g1[2], g1[3]); *(v4u*)(rowp) = w; }
                { v4u w; w.x = pg8::cvt_pk_bf16(l0[0], l0[1]); w.y = pg8::cvt_pk_bf16(l0[2], l0[3]); w.z = pg8::cvt_pk_bf16(l1[0], l1[1]); w.w = pg8::cvt_pk_bf16(l1[2], l1[3]); *(v4u*)(rowp + 128) = w; } }
    }
};
struct EpiBranch { static constexpr bool BIAS_INIT = false; static constexpr bool MIDK = true; static constexpr bool PROBE2X = false;
    static constexpr bool PERM = true;
    bf16* O; const bf16* proj;
    __device__ __forceinline__ void mid(pg8::f32x4 (&acc)[2][2][4][2], const pg8::Unit& u, int wr, int wc, int fr, int fq) const {
        int row0 = u.pm * 256 + wr * 64 + fr; const int ci = wc * 32 + 8 * fq;
        asm volatile("" : "+v"(row0));
#pragma unroll
        for (int ai = 0; ai < 2; ++ai) {
            v4u R[4][2];
#pragma unroll
            for (int m = 0; m < 4; ++m) { const bf16* gp = proj + (size_t)(row0 + ai * 128 + m * 16) * NPROJ + C_GT + 512 * u.pn + ci;
#pragma unroll
                for (int bj = 0; bj < 2; ++bj) R[m][bj] = *(const v4u*)(gp + bj * 256); }
            __builtin_amdgcn_sched_barrier(0);
#pragma unroll
            for (int m = 0; m < 4; ++m)
#pragma unroll
                for (int bj = 0; bj < 2; ++bj) { const v4u g = R[m][bj];
                    acc[ai][bj][m][0] = acc[ai][bj][m][0] * (pg8::f32x4){bflo(g.x), bfhi(g.x), bflo(g.y), bfhi(g.y)}; acc[ai][bj][m][1] = acc[ai][bj][m][1] * (pg8::f32x4){bflo(g.z), bfhi(g.z), bflo(g.w), bfhi(g.w)}; }
            __builtin_amdgcn_sched_barrier(0);
        }
    }
    __device__ __forceinline__ void operator()(const pg8::f32x4 (&acc)[2][2][4][2], const pg8::Unit& u, int wr, int wc, int fr, int fq, const PG8_LAS unsigned char* tab) const {
        const int row0 = u.pm * 256 + wr * 64 + fr, col0 = u.pn * 256 + wc * 32 + 8 * fq;
        v4u Lq[2][4][2];
#pragma unroll
        for (int ai = 0; ai < 2; ++ai)
#pragma unroll
            for (int m = 0; m < 4; ++m) { const bf16* gp = proj + (size_t)(row0 + ai * 128 + m * 16) * NPROJ + C_GT + 512 * u.pn + 128 + wc * 32 + 8 * fq;
#pragma unroll
                for (int bj = 0; bj < 2; ++bj) Lq[ai][m][bj] = *(const v4u*)(gp + bj * 256); }
        __builtin_amdgcn_sched_barrier(0);
#pragma unroll
        for (int ai = 0; ai < 2; ++ai)
#pragma unroll
            for (int m = 0; m < 4; ++m) { const size_t r = (size_t)(row0 + ai * 128 + m * 16); bf16* rowp = O + r * D + col0;
#pragma unroll
                for (int bj = 0; bj < 2; ++bj) { const v4u l = Lq[ai][m][bj];
                    const pg8::f32x4 v0 = acc[ai][bj][m][0], v1 = acc[ai][bj][m][1];
                    const float o[8] = {v0[0] * bflo(l.x), v0[1] * bfhi(l.x), v0[2] * bflo(l.y), v0[3] * bfhi(l.y), v1[0] * bflo(l.z), v1[1] * bfhi(l.z), v1[2] * bflo(l.w), v1[3] * bfhi(l.w)};
                    v4u w; w.x = pg8::cvt_pk_bf16(o[0], o[1]); w.y = pg8::cvt_pk_bf16(o[2], o[3]); w.z = pg8::cvt_pk_bf16(o[4], o[5]); w.w = pg8::cvt_pk_bf16(o[6], o[7]);
                    *(v4u*)(rowp + bj * 128) = w; } }
    }
};
struct EpiOut { static constexpr bool BIAS_INIT = false; static constexpr bool MIDK = false; static constexpr bool PROBE2X = (PROBE_EPI & 4) != 0;
    static constexpr bool PERM = true;
    bf16* X2; const float* x; const float* mod;
    __device__ __forceinline__ void operator()(const pg8::f32x4 (&acc)[2][2][4][2], const pg8::Unit& u, int wr, int wc, int fr, int fq, const PG8_LAS unsigned char* tab) const {
        const int row0 = u.pm * 256 + wr * 64 + fr, col0 = u.pn * 256 + wc * 32 + 8 * fq; const int b = u.pm >> 5;
        pg8::f32x4 gm[2][2];
#pragma unroll
        for (int bj = 0; bj < 2; ++bj)
#pragma unroll
            for (int n = 0; n < 2; ++n) gm[bj][n] = *(const pg8::f32x4*)(mod + b * 6144 + 2048 + col0 + bj * 128 + n * 4);
#pragma unroll
        for (int ai = 0; ai < 2; ++ai) {
            pg8::f32x4 X[4][2][2];
#pragma unroll
            for (int m = 0; m < 4; ++m) { const size_t off = (size_t)(row0 + ai * 128 + m * 16) * D + col0;
#pragma unroll
                for (int bj = 0; bj < 2; ++bj) { X[m][bj][0] = *(const pg8::f32x4*)(x + off + bj * 128); X[m][bj][1] = *(const pg8::f32x4*)(x + off + bj * 128 + 4); } }
            __builtin_amdgcn_sched_barrier(0);
#pragma unroll
            for (int m = 0; m < 4; ++m) { const size_t off = (size_t)(row0 + ai * 128 + m * 16) * D + col0;
#pragma unroll
                for (int bj = 0; bj < 2; ++bj) {
                    const pg8::f32x4 v0 = X[m][bj][0] + gm[bj][0] * acc[ai][bj][m][0], v1 = X[m][bj][1] + gm[bj][1] * acc[ai][bj][m][1];
                    v4u w; w.x = pg8::cvt_pk_bf16(v0[0], v0[1]); w.y = pg8::cvt_pk_bf16(v0[2], v0[3]); w.z = pg8::cvt_pk_bf16(v1[0], v1[1]); w.w = pg8::cvt_pk_bf16(v1[2], v1[3]);
                    *(v4u*)(X2 + off + bj * 128) = w; } }
            __builtin_amdgcn_sched_barrier(0);
        }
    }
};
struct EpiMoe1 { static constexpr bool BIAS_INIT = true; static constexpr bool MIDK = false; static constexpr bool PROBE2X = (PROBE_EPI & 8) != 0;
    static constexpr bool PERM = true;
    bf16* ACT;
    __device__ __forceinline__ void operator()(const pg8::f32x4 (&acc)[2][2][4][2], const pg8::Unit& u, int wr, int wc, int fr, int fq, const PG8_LAS unsigned char* tab) const {
        const int row0 = u.pm * 256 + wr * 64 + fr, col0 = u.pn * 256 + wc * 32 + 8 * fq;
#pragma unroll
        for (int ai = 0; ai < 2; ++ai)
#pragma unroll
            for (int m = 0; m < 4; ++m) { bf16* rowp = ACT + (size_t)(row0 + ai * 128 + m * 16) * FF + (col0 >> 1);
#pragma unroll
                for (int bj = 0; bj < 2; ++bj) { const pg8::f32x4 v0 = acc[ai][bj][m][0], v1 = acc[ai][bj][m][1];
                    typedef float f2 __attribute__((ext_vector_type(2)));
                    f2 g0 = {v0[0], v0[2]}, g1 = {v1[0], v1[2]}, l0 = {v0[1], v0[3]}, l1 = {v1[1], v1[3]};
                    g0 = __builtin_elementwise_min(g0, (f2){7.f, 7.f}); g1 = __builtin_elementwise_min(g1, (f2){7.f, 7.f});
                    l0 = __builtin_elementwise_min(__builtin_elementwise_max(l0, (f2){-7.f, -7.f}), (f2){7.f, 7.f}) + 1.f; l1 = __builtin_elementwise_min(__builtin_elementwise_max(l1, (f2){-7.f, -7.f}), (f2){7.f, 7.f}) + 1.f;
                    const f2 t0 = g0 * (-1.702f * 1.4426950408889634f), t1 = g1 * (-1.702f * 1.4426950408889634f);
                    f2 d0, d1; d0.x = __builtin_amdgcn_exp2f(t0.x); d0.y = __builtin_amdgcn_exp2f(t0.y); d1.x = __builtin_amdgcn_exp2f(t1.x); d1.y = __builtin_amdgcn_exp2f(t1.y);
                    d0 = d0 + 1.f; d1 = d1 + 1.f;
                    f2 r0, r1; r0.x = __builtin_amdgcn_rcpf(d0.x); r0.y = __builtin_amdgcn_rcpf(d0.y); r1.x = __builtin_amdgcn_rcpf(d1.x); r1.y = __builtin_amdgcn_rcpf(d1.y);
                    const f2 a0 = (g0 * r0) * l0, a1 = (g1 * r1) * l1;
                    const float a[4] = {a0.x, a0.y, a1.x, a1.y};
                    v2u w; w.x = pg8::cvt_pk_bf16(a[0], a[1]); w.y = pg8::cvt_pk_bf16(a[2], a[3]);
                    *(v2u*)(rowp + bj * 64) = w; } }
    }
};
struct EpiMoe2 { static constexpr bool BIAS_INIT = true; static constexpr bool MIDK = false; static constexpr bool PROBE2X = (PROBE_EPI & 16) != 0;
    static constexpr bool PERM = true;
    bf16* Y;
    __device__ __forceinline__ void operator()(const pg8::f32x4 (&acc)[2][2][4][2], const pg8::Unit& u, int wr, int wc, int fr, int fq, const PG8_LAS unsigned char* tab) const {
        const int rl0 = wr * 64 + fr, col0 = u.pn * 256 + wc * 32 + 8 * fq;
        const PG8_LAS int* idp = (const PG8_LAS int*)tab; const PG8_LAS float* gwp = (const PG8_LAS float*)(tab + 2048);
#pragma unroll
        for (int ai = 0; ai < 2; ++ai)
#pragma unroll
            for (int m = 0; m < 4; ++m) { const int rl = rl0 + ai * 128 + m * 16;
                if (rl < u.nvalid) { const int a = idp[rl]; const float gw = gwp[rl]; bf16* rowp = Y + (size_t)a * D + col0;
#pragma unroll
                    for (int bj = 0; bj < 2; ++bj) { const pg8::f32x4 v0 = acc[ai][bj][m][0] * gw, v1 = acc[ai][bj][m][1] * gw;
                        v4u w; w.x = pg8::cvt_pk_bf16(v0[0], v0[1]); w.y = pg8::cvt_pk_bf16(v0[2], v0[3]); w.z = pg8::cvt_pk_bf16(v1[0], v1[1]); w.w = pg8::cvt_pk_bf16(v1[2], v1[3]);
                        *(v4u*)(rowp + bj * 128) = w; } } }
    }
};

__device__ __forceinline__ void moe_tile_table(const unsigned* cnt, int* ts, int tid) {
    if (tid == 0) { int acc = 0; for (int e = 0; e < NE; ++e) { ts[e] = acc; acc += (int)((cnt[e] + 255u) >> 8); ts[40 + e] = (int)cnt[e]; } ts[NE] = acc; }
    __syncthreads();
}

template <int I> struct SolveRow {
    static __device__ __forceinline__ void run(float (&X)[64], const LAS float* AM, const LAS float* GT, const LAS bf16* src, float sel, const f32x4 (&cur)[16], float ycur) {
        f32x4 nxt[16]; float ynxt = 0.f;
        if constexpr (I + 1 < 64) {
#pragma unroll
            for (int j4 = 0; j4 < (I + 4) / 4; ++j4) nxt[j4] = *(const LAS f32x4*)(AM + (I + 1) * 64 + 4 * j4);
            const float eg_ = GT[128 + I + 1]; ynxt = GT[I + 1] * bf1(src[(I + 1) * 136]) * (sel + (1.f - sel) * eg_);
        }
        __builtin_amdgcn_sched_barrier(0);
        float acc = ycur, acc2 = 0.f;
#pragma unroll
        for (int j4 = 0; j4 < (I + 3) / 4; ++j4) { const f32x4 a4 = cur[j4];
            if (4 * j4 + 0 < I) acc -= a4[0] * X[4 * j4 + 0]; if (4 * j4 + 1 < I) acc2 -= a4[1] * X[4 * j4 + 1];
            if (4 * j4 + 2 < I) acc -= a4[2] * X[4 * j4 + 2]; if (4 * j4 + 3 < I) acc2 -= a4[3] * X[4 * j4 + 3]; }
        X[I] = acc + acc2;
        __builtin_amdgcn_sched_barrier(0);
        if constexpr (I + 1 < 64) SolveRow<I + 1>::run(X, AM, GT, src, sel, nxt, ynxt);
    }
};

#define GDN_ITEM(k_, bh_, n_) do { if (mode == 0) { bh_ = blk >> 4; n_ = (blk & 15) + 16 * (k_); } else { const int q__ = blk + nb * (k_); bh_ = q__ & 15; n_ = NSPLIT + (q__ >> 4); } } while (0)
__device__ __forceinline__ void gdn_prep_items(unsigned char* lds, unsigned char* ws, const bf16* PROJ, const float* BA, const float* gconv, const float* galog, const float* gdt, const int mode, const int blk, const int nb, const int cnt, unsigned* gctl = nullptr) {
        {
            int tid = threadIdx.x; asm volatile("" : "+v"(tid)); int lane = tid & 63, wave = __builtin_amdgcn_readfirstlane(tid >> 6);
            unsigned char* L = lds;
            bf16* QB = (bf16*)(L + 0); bf16* KB = (bf16*)(L + 17408); bf16* VB = (bf16*)(L + 34816);
            float* AM = (float*)(L + 52224);
            unsigned char* QKS = L + 68608;
            unsigned char* WNS = L + 76800;
            float* CW = (float*)(L + 93184);
            float* GT = (float*)(L + 99328);
            unsigned char* GBLOB = ws + WS_GBLOB; unsigned char* GU = ws + WS_GU; float* GLv = (float*)(ws + WS_GL);
            unsigned char* RAWG = L + 100352;
            int hcur = -1;
#define GDN_DMA(b_, h_, n_) do { const size_t mm_ = (size_t)(b_) * SEQ + (n_) * 64; \
                for (int k_ = wave; k_ < 51; k_ += NWAVES) { int q_ = k_ * 64 + lane; q_ = q_ < 3216 ? q_ : 3215; const int p_ = q_ >> 4, c16_ = q_ & 15, row_ = p_ / 3, X_ = p_ - row_ * 3; \
                    long mr_ = (long)mm_ - 3 + row_; if ((n_) == 0 && row_ < 3) mr_ = (long)mm_; \
                    __builtin_amdgcn_global_load_lds((const unsigned*)(PROJ + (size_t)mr_ * NPROJ + X_ * 512 + (h_) * 128 + c16_ * 8), (LAS unsigned*)((LAS unsigned char*)RAWG + k_ * 1024), 16, 0, 0); } } while (0)
            if (cnt > 0) {
            int bh0, n0_; GDN_ITEM(0, bh0, n0_);
            GDN_DMA(bh0 >> 2, bh0 & 3, n0_);
            float blq = 0.f, alq = 0.f;
            if (wave == 0) { const size_t mq = (size_t)(bh0 >> 2) * SEQ + n0_ * 64 + lane; blq = BA[mq * 8 + (bh0 & 3)]; alq = BA[mq * 8 + 4 + (bh0 & 3)]; }
            asm volatile("s_waitcnt vmcnt(0)" ::: "memory");
            for (int ii = 0; ii < cnt; ++ii) {
                int tid_l = threadIdx.x; asm volatile("" : "+v"(tid_l));
                const int tid = tid_l, lane = tid & 63, wave = __builtin_amdgcn_readfirstlane(tid >> 6);
                int bh, n; GDN_ITEM(ii, bh, n); const int b = bh >> 2, h = bh & 3, it = bh * 128 + n;
                int bh2 = bh, n2 = n; if (ii + 1 < cnt) GDN_ITEM(ii + 1, bh2, n2);
                if (h != hcur) { hcur = h; for (int i = tid; i < 1536; i += NTHR) { const int X = i >> 9, r = i & 511, j = r >> 7, d = r & 127; CW[i] = gconv[j * 1536 + X * 512 + h * 128 + d]; } }
                const size_t m0 = (size_t)b * SEQ + n * 64;
                unsigned char* blob = GBLOB + (size_t)it * 57344;
                const __amdgpu_buffer_rsrc_t rb_ = __builtin_amdgcn_make_buffer_rsrc((void*)pg8::uptr((const char*)blob), 0, 57344, 0x00020000);
                const __amdgpu_buffer_rsrc_t ru_ = __builtin_amdgcn_make_buffer_rsrc((void*)pg8::uptr((const char*)(GU + (size_t)it * 16384)), 0, 16384, 0x00020000);
#define WT16(rs_, off_, v_) __builtin_amdgcn_raw_buffer_store_b128((v_), (rs_), (unsigned)(off_), 0,   16)
                LBAR();
                if (mode == 1 && ii > 0) {
                    const int sp_ = gdn_stage_of((blk + nb * (ii - 1)) >> 4), sc_ = gdn_stage_of(n - NSPLIT);
                    if (sp_ != sc_) { asm volatile("s_waitcnt vmcnt(0)" ::: "memory"); LBAR();
                        if (tid == 0) { for (int s_ = sp_; s_ < sc_; ++s_) __hip_atomic_fetch_add(gctl + CW_GDN2 + s_, 1u, RLX_AGENT); } }
                }
                for (int rc_ = 0; rc_ < ((PROBE_SUB & 64) ? 2 : 1); ++rc_)
                {
                    const int tok = tid >> 3, d0 = (tid & 7) * 16;
#pragma unroll
                    for (int X = 0; X < 3; ++X) {
                        float y[16];
#pragma unroll
                        for (int i = 0; i < 16; ++i) y[i] = 0.f;
#pragma unroll
                        for (int j = 0; j < 4; ++j) {
                            if (n * 64 + tok - 3 + j >= 0) {
                                const unsigned char* src = RAWG + (((tok + j) * 3 + X) * 16 + (d0 >> 3)) * 16;
                                const v4u r0 = *(const v4u*)src, r1 = *(const v4u*)(src + 16);
                                const float* cw = CW + (X * 4 + j) * 128 + d0;
                                y[0] += cw[0] * bflo(r0.x); y[1] += cw[1] * bfhi(r0.x); y[2] += cw[2] * bflo(r0.y); y[3] += cw[3] * bfhi(r0.y);
                                y[4] += cw[4] * bflo(r0.z); y[5] += cw[5] * bfhi(r0.z); y[6] += cw[6] * bflo(r0.w); y[7] += cw[7] * bfhi(r0.w);
                                y[8] += cw[8] * bflo(r1.x); y[9] += cw[9] * bfhi(r1.x); y[10] += cw[10] * bflo(r1.y); y[11] += cw[11] * bfhi(r1.y);
                                y[12] += cw[12] * bflo(r1.z); y[13] += cw[13] * bfhi(r1.z); y[14] += cw[14] * bflo(r1.w); y[15] += cw[15] * bfhi(r1.w);
                            }
                        }
                        float ss = 0.f;
#pragma unroll
                        for (int i = 0; i < 16; ++i) { y[i] = siluf_(y[i]); ss += y[i] * y[i]; }
                        if (X < 2) { ss += __shfl_xor(ss, 1); ss += __shfl_xor(ss, 2); ss += __shfl_xor(ss, 4);
                            const float sc = rsqrtf(ss + EPS) * (X == 0 ? 0.08838834764831845f : 1.f);
#pragma unroll
                            for (int i = 0; i < 16; ++i) y[i] *= sc; }
                        bf16* dst = (X == 0 ? QB : X == 1 ? KB : VB) + tok * 136 + d0;
                        v4u o0, o1; o0.x = pkbf(y[0], y[1]); o0.y = pkbf(y[2], y[3]); o0.z = pkbf(y[4], y[5]); o0.w = pkbf(y[6], y[7]);
                        o1.x = pkbf(y[8], y[9]); o1.y = pkbf(y[10], y[11]); o1.z = pkbf(y[12], y[13]); o1.w = pkbf(y[14], y[15]);
                        *(v4u*)dst = o0; *(v4u*)(dst + 8) = o1;
                    }
                }
                if (wave == 0) {
                    const float bl = blq, al = alq;
                    if (ii + 1 < cnt) { const size_t mq = (size_t)(bh2 >> 2) * SEQ + n2 * 64 + lane; blq = BA[mq * 8 + (bh2 & 3)]; alq = BA[mq * 8 + 4 + (bh2 & 3)]; }
                    const float beta = sigmoidf_(bl); const float g = -__expf(galog[h]) * softplusf_(al + gdt[h]);
                    float gc = g;
#pragma unroll
                    for (int o = 1; o < 64; o <<= 1) { const float t = __shfl_up(gc, o); if (lane >= o) gc += t; }
                    const float gl = __shfl(gc, 63);
                    GT[lane] = beta; GT[64 + lane] = gc; GT[128 + lane] = __expf(gc); GT[192 + lane] = __expf(gl - gc);
                    if (lane == 0) { GLv[it] = __expf(gl); *(float*)(QKS + 2048) = __expf(gl); }
                }
                LBAR();
                if (ii + 1 < cnt) GDN_DMA(bh2 >> 2, bh2 & 3, n2);
                if (wave < 6) {
                    const int tl = wave % 3, a = tl >= 1 ? 1 : 0, bb = tl == 2 ? 1 : 0; const bool isqk = wave >= 3;
                    const bf16* Asrc = isqk ? QB : KB; const int r = lane & 31, hh = lane >> 5;
                    f32x16 acc;
#pragma unroll
                    for (int i = 0; i < 16; ++i) acc[i] = 0.f;
#pragma unroll
                    for (int kk = 0; kk < 8; ++kk) { const pg8::bf16x8 af = *(const pg8::bf16x8*)(Asrc + (32 * a + r) * 136 + 16 * kk + 8 * hh), bfr = *(const pg8::bf16x8*)(KB + (32 * bb + r) * 136 + 16 * kk + 8 * hh);
                        acc = __builtin_amdgcn_mfma_f32_32x32x16_bf16(af, bfr, acc, 0, 0, 0); }
                    const int j = 32 * bb + r; const float gcj = GT[64 + j];
                    const int kq = j >> 4, o = j & 15, hh2 = (o >> 2) & 1, jj = ((o >> 3) << 2) | (o & 3);
#pragma unroll
                    for (int reg = 0; reg < 16; ++reg) { const int i = 32 * a + (reg & 3) + 8 * (reg >> 2) + 4 * hh; const float dec = __expf(fminf(GT[64 + i] - gcj, 0.f));
                        if (!isqk) AM[i * 64 + j] = (i > j) ? GT[i] * acc[reg] * dec : 0.f;
                        else { const float val = (i >= j) ? acc[reg] * dec : 0.f; *(bf16*)(QKS + ((a * 4 + kq) * 64 + hh2 * 32 + (i & 31)) * 16 + jj * 2) = (bf16)f2bf(val); } }
                } else {
#pragma unroll 2
                    for (int q = 0; q < 8; ++q) { const int idx = (tid - 384) + 128 * q, blk = idx >> 6, l = idx & 63, r = l & 31, hh = l >> 5, a = blk >> 3, kq = blk & 7, i = 32 * a + r;
                        const v2u lo = *(const v2u*)(QB + i * 136 + 16 * kq + 4 * hh), hi2 = *(const v2u*)(QB + i * 136 + 16 * kq + 8 + 4 * hh); const float eg = GT[128 + i];
                        v4u o4; o4.x = pkbf(bflo(lo.x) * eg, bfhi(lo.x) * eg); o4.y = pkbf(bflo(lo.y) * eg, bfhi(lo.y) * eg); o4.z = pkbf(bflo(hi2.x) * eg, bfhi(hi2.x) * eg); o4.w = pkbf(bflo(hi2.y) * eg, bfhi(hi2.y) * eg);
                        WT16(rb_, (16 + blk) * 1024 + l * 16, o4); }
                }
                LBAR();
                if (tid < 256) {
                    const int c = tid; const bool isv = c < 128; const bf16* src = isv ? (VB + c) : (KB + (c - 128));
                    float X[64];
                    { const LAS float* AMl = (const LAS float*)AM; const LAS float* GTl = (const LAS float*)GT; const LAS bf16* srcl = (const LAS bf16*)src;
                      asm volatile("" : "+v"(AMl), "+v"(GTl), "+v"(srcl));
                      const float sel_ = isv ? 1.f : 0.f; f32x4 c0[16]; const float y0 = GTl[0] * bf1(srcl[0]) * (sel_ + (1.f - sel_) * GTl[128]);
                      SolveRow<0>::run(X, AMl, GTl, srcl, sel_, c0, y0);
                      if (PROBE_SUB & 32) { asm volatile("" : "+v"(AMl), "+v"(GTl), "+v"(srcl)); SolveRow<0>::run(X, AMl, GTl, srcl, sel_, c0, y0); } }
                    asm volatile("s_waitcnt vmcnt(0)" ::: "memory");
                    if (isv) {
                        const int s4 = c >> 5, cc = c & 31;
#pragma unroll
                        for (int a = 0; a < 2; ++a)
#pragma unroll
                            for (int hh = 0; hh < 2; ++hh) { v4u u0, u1;
                                u0.x = pkbf(X[32 * a + 4 * hh + 0], X[32 * a + 4 * hh + 1]); u0.y = pkbf(X[32 * a + 4 * hh + 2], X[32 * a + 4 * hh + 3]);
                                u0.z = pkbf(X[32 * a + 8 + 4 * hh + 0], X[32 * a + 8 + 4 * hh + 1]); u0.w = pkbf(X[32 * a + 8 + 4 * hh + 2], X[32 * a + 8 + 4 * hh + 3]);
                                u1.x = pkbf(X[32 * a + 16 + 4 * hh + 0], X[32 * a + 16 + 4 * hh + 1]); u1.y = pkbf(X[32 * a + 16 + 4 * hh + 2], X[32 * a + 16 + 4 * hh + 3]);
                                u1.z = pkbf(X[32 * a + 24 + 4 * hh + 0], X[32 * a + 24 + 4 * hh + 1]); u1.w = pkbf(X[32 * a + 24 + 4 * hh + 2], X[32 * a + 24 + 4 * hh + 3]);
                                const int uo_ = ((s4 * 2 + a) * 64 + hh * 32 + cc) * 32; WT16(ru_, uo_, u0); WT16(ru_, uo_ + 16, u1); }
                    } else {
                        const int dk = c - 128, kq = dk >> 4, o = dk & 15, hh2 = (o >> 2) & 1, jj = ((o >> 3) << 2) | (o & 3);
#pragma unroll
                        for (int i = 0; i < 64; ++i) *(bf16*)(WNS + (((i >> 5) * 8 + kq) * 64 + hh2 * 32 + (i & 31)) * 16 + jj * 2) = (bf16)f2bf(-X[i]);
                    }
                } else {
                    v4u ok[4], oq[2];
#pragma unroll
                    for (int q = 0; q < 4; ++q) { const int idx = (tid - 256) + 256 * q, blk = idx >> 6, l = idx & 63, r = l & 31, hh = l >> 5, ip = blk >> 2, kq = blk & 3, dk = 32 * ip + r;
                        float vv[8];
#pragma unroll
                        for (int j = 0; j < 8; ++j) { const int tk = 16 * kq + 8 * (j >> 2) + 4 * hh + (j & 3); vv[j] = bf1(KB[tk * 136 + dk]) * GT[192 + tk]; }
                        ok[q].x = pkbf(vv[0], vv[1]); ok[q].y = pkbf(vv[2], vv[3]); ok[q].z = pkbf(vv[4], vv[5]); ok[q].w = pkbf(vv[6], vv[7]); }
#pragma unroll
                    for (int q = 0; q < 2; ++q) { const int idx = (tid - 256) + 256 * q; oq[q] = *(const v4u*)(QKS + idx * 16); }
                    asm volatile("s_waitcnt vmcnt(0)" ::: "memory");
#pragma unroll
                    for (int q = 0; q < 4; ++q) { const int idx = (tid - 256) + 256 * q, blk = idx >> 6, l = idx & 63; WT16(rb_, (40 + blk) * 1024 + l * 16, ok[q]); }
#pragma unroll
                    for (int q = 0; q < 2; ++q) { const int idx = (tid - 256) + 256 * q; WT16(rb_, 32 * 1024 + idx * 16, oq[q]); }
                }
                LBAR();
#pragma unroll
                for (int q = 0; q < 2; ++q) { const int idx = tid + 512 * q; WT16(rb_, idx * 16, *(const v4u*)(WNS + idx * 16)); }
            }
            asm volatile("s_waitcnt vmcnt(0)" ::: "memory");
            }
#undef GDN_DMA
#undef WT16
        }
}
#undef GDN_ITEM

typedef const Args __attribute__((address_space(4)))* ArgsP;
__device__ __forceinline__ ArgsP launder_args() { ArgsP p = (ArgsP)__builtin_amdgcn_kernarg_segment_ptr(); asm volatile("" : "+s"(p)); return p; }
#define PHASE_PTRS \
    int tid = threadIdx.x; asm volatile("" : "+v"(tid)); const int lane = tid & 63, wave = __builtin_amdgcn_readfirstlane(tid >> 6); \
    const int G = gridDim.x, bid = blockIdx.x; const int vcu = (G % 8 == 0) ? (bid % 8) * (G / 8) + bid / 8 : bid; \
    const int gw = vcu * NWAVES + wave, NGW = G * NWAVES; (void)lane; (void)gw; (void)NGW; \
    ArgsP ap = launder_args(); unsigned char* ws = ap->ws; unsigned* ctl = (unsigned*)(ws + WS_CTL); \
    const float* x = ap->in[I_X]; float* MOD = (float*)(ws + WS_MOD); float* BA = (float*)(ws + WS_BA); float* BG = (float*)(ws + WS_BG); \
    bf16* H = (bf16*)(ws + WS_H); bf16* PROJ = (bf16*)(ws + WS_PROJ); bf16* OGDN = (bf16*)(ws + WS_OCAT); bf16* OLRU = (bf16*)(ws + WS_OCAT) + 512; \
    bf16* HLOC = (bf16*)(ws + WS_HLOC); bf16* PLOC = (bf16*)(ws + WS_PLOC); float* LEND = (float*)(ws + WS_LEND); \
    bf16* MERGED = (bf16*)(ws + WS_MERGED); bf16* X2 = (bf16*)(ws + WS_X2); int* TOPI = (int*)(ws + WS_TOPI); float* TOPW = (float*)(ws + WS_TOPW); \
    int* LIST = (int*)(ws + WS_LIST); bf16* XS = (bf16*)(ws + WS_XS); bf16* ACT = (bf16*)(ws + WS_ACT); bf16* Y = (bf16*)(ws + WS_Y); \
    unsigned* CNT = ctl + CW_CNT; \
    (void)x; (void)MOD; (void)BA; (void)BG; (void)H; (void)PROJ; (void)OGDN; (void)OLRU; (void)HLOC; (void)PLOC; (void)LEND; (void)MERGED; (void)X2; (void)TOPI; (void)TOPW; (void)LIST; (void)XS; (void)ACT; (void)Y; (void)CNT;
__global__ void __launch_bounds__(NTHR, 2) mk_fwd(Args args) {
    extern __shared__ __attribute__((aligned(16))) unsigned char lds[];
    const int tid0 = threadIdx.x;
    unsigned* ctl0 = (unsigned*)(args.ws + WS_CTL);
    volatile LAS unsigned* MISC = (volatile LAS unsigned*)((LAS unsigned char*)lds + MISC_OFF);
    for (int u = tid0; u < (LDS_BYTES - LDSCTL_OFF) / 4; u += NTHR) ((LAS unsigned*)((LAS unsigned char*)lds + LDSCTL_OFF))[u] = 0u;
    __syncthreads();
    XcdBarrier bar; bar.bar = ctl0 + CW_BAR; bar.x = 0; bar.st = nullptr;
    if (N_LAUNCHES == 1) bar = xcd_barrier_post(ctl0 + CW_BAR, MISC + 8);
    const int lo = args.ph_lo, hi = args.ph_hi;
#ifndef PH_MASK
#define PH_MASK 0x1fff
#endif
#define IN(k) (((PH_MASK >> (k)) & 1) && lo <= (k) && (k) < hi)
#ifndef PROBE_DUP
#define PROBE_DUP 0
#endif
#ifndef TR_IN_P0
#define TR_IN_P0 0
#endif
#define NREP(k) ((((PROBE_DUP) >> (k)) & 1) ? 2 : 1)
#define SEAM(k) do { if (IN(k) && IN((k) + 1)) xcd_barrier(bar); } while (0)

    for (int rep_ = 0; rep_ < NREP(0); ++rep_) { if (IN(0)) {
        PHASE_PTRS
        {
            float* cact = (float*)lds;
            float* red = (float*)(lds + 16384);
            if (bid < 192) {
                for (int i = tid; i < 4096; i += NTHR) cact[i] = siluf_(ap->in[I_C][i]);
                __syncthreads();
                const int col = tid & 31, kg = tid >> 5; const float* wp = ap->in[I_WADA] + 32 * bid + col;
                float a0 = 0.f, a1 = 0.f, a2 = 0.f, a3 = 0.f;
                float wv[64];
#pragma unroll
                for (int i = 0; i < 64; ++i) wv[i] = wp[(size_t)(kg + 16 * i) * 6144];
                __builtin_amdgcn_sched_barrier(0);
#pragma unroll
                for (int i = 0; i < 64; ++i) { const int k = kg + 16 * i; const float w = wv[i];
                    a0 += cact[k] * w; a1 += cact[1024 + k] * w; a2 += cact[2048 + k] * w; a3 += cact[3072 + k] * w; }
                red[(kg * 4 + 0) * 32 + col] = a0; red[(kg * 4 + 1) * 32 + col] = a1; red[(kg * 4 + 2) * 32 + col] = a2; red[(kg * 4 + 3) * 32 + col] = a3;
                __syncthreads();
                if (tid < 128) { const int b = tid >> 5, c2 = tid & 31; float s = 0.f;
                    for (int g = 0; g < 16; ++g) s += red[(g * 4 + b) * 32 + c2];
                    MOD[b * 6144 + 32 * bid + c2] = s + ap->in[I_BADA][32 * bid + c2]; }
            }
            __syncthreads();
        }
        float* scr = (float*)(lds + wave * 16384);
        constexpr int IT_A = 16 * 64, IT_B = 16 * 32, IT_G = 16 * 16 * 4, IT_BG = 8 * 32, IT_O = 16 * 32, IT_1 = 16 * 64, IT_2 = 16 * 32;
        constexpr int NIT = IT_A + IT_B + IT_G + 2 * IT_BG + IT_O;
        for (int it = gw; it < NIT; it += NGW) {
            int r = it;
            if (r < IT_A) { p0_transpose_item(ap->in[I_WIN], DIN, D, 64, (bf16*)(ws + WS_WIN), scr, r, lane); continue; } r -= IT_A;
            if (r < IT_B) { p0_transpose_item(ap->in[I_WIN] + 2056, DIN, D, 32, (bf16*)(ws + WS_WIN) + (size_t)2048 * D, scr, r, lane); continue; } r -= IT_B;
            if (r < IT_G) { const int seg = r >> 6, j = seg >> 1, gl_ = seg & 1;
                p0_transpose_item(ap->in[I_WIN] + 2056 + 1024 + gl_ * 1024 + 128 * j, DIN, D, 4, (bf16*)(ws + WS_WIN) + (size_t)(C_GT + 256 * j + 128 * gl_) * D, scr, r & 63, lane); continue; } r -= IT_G;
            if (r < IT_BG) { p0_transpose_item(ap->in[I_WBG], D, 1024, 32, (bf16*)(ws + WS_WBG), scr, r, lane); continue; } r -= IT_BG;
            if (r < IT_BG) { p0_transpose_item(ap->in[I_WBL], D, 1024, 32, (bf16*)(ws + WS_WBG) + 512, scr, r, lane); continue; } r -= IT_BG;
            { p0_transpose_item(ap->in[I_WOUT], D, D, 32, (bf16*)(ws + WS_WOUT), scr, r, lane); }
        }
        if (TR_IN_P0) { constexpr int IT_1b = 16 * 64, IT_2b = 16 * 32;
            for (int it = gw; it < NE * (IT_1b + IT_2b); it += NGW) {
                if (it < NE * IT_1b) { const int e = it / IT_1b; p0_transpose_item(ap->in[I_W1] + (size_t)e * D * 2048, 2048, D, 64, (bf16*)(ws + WS_W1) + (size_t)e * 2048 * D, scr, it % IT_1b, lane); }
                else { const int r = it - NE * IT_1b, e = r / IT_2b; p0_transpose_item(ap->in[I_W2] + (size_t)e * FF * D, D, FF, 32, (bf16*)(ws + WS_W2) + (size_t)e * D * FF, scr, r % IT_2b, lane); } } }
    }
    SEAM(0); }

    for (int rep_ = 0; rep_ < NREP(1); ++rep_) { if (IN(1)) {
        PHASE_PTRS
        {
            bf16* WGH = (bf16*)(ws + WS_WGH); bf16* WGL = (bf16*)(ws + WS_WGL); float* CB = (float*)(ws + WS_CB);
            const float* wr = ap->in[I_WR]; const float* nf = ap->in[I_NFFN];
            for (int i = vcu * NTHR + tid; i < 4 * 32 * 1024; i += G * NTHR) { const int b = i >> 15, e = (i >> 10) & 31, k = i & 1023;
                const float val = wr[k * 32 + e] * nf[k] * (1.f + MOD[b * 6144 + 4096 + k]); const unsigned hi = f2bf(val); const float lo = val - bf1((bf16)hi);
                WGH[i] = (bf16)hi; WGL[i] = (bf16)f2bf(lo); }
            if (gw < 128) { const int b = gw >> 5, e = gw & 31; float a = 0.f;
                for (int k = lane; k < 1024; k += 64) a += MOD[b * 6144 + 3072 + k] * wr[k * 32 + e];
                a = wave_sum(a); if (lane == 0) CB[gw] = a + ap->in[I_BR][e]; }
        }
        float* w8 = (float*)lds;
        for (int i = tid; i < 8192; i += NTHR) w8[i] = ap->in[I_WIN][(size_t)(i >> 3) * DIN + 2048 + (i & 7)];
        __syncthreads();
        const float* nm = ap->in[I_NMIX];
        f32x4 xq[4], xn[4];
#define P1_LOAD(dst_, m_) do { const float* xr_ = x + (size_t)(m_) * D; _Pragma("unroll") for (int c_ = 0; c_ < 2; ++c_) _Pragma("unroll") for (int q_ = 0; q_ < 2; ++q_) dst_[c_ * 2 + q_] = *(const f32x4*)(xr_ + c_ * 512 + lane * 8 + q_ * 4); } while (0)
        int bcur = -1; float gq[16], sq[16];
        f32x4 wreg[16][2];
#pragma unroll
        for (int c = 0; c < 2; ++c)
#pragma unroll
            for (int j = 0; j < 8; ++j) { const int k = c * 512 + lane * 8 + j; wreg[c * 8 + j][0] = *(const f32x4*)(w8 + k * 8); wreg[c * 8 + j][1] = *(const f32x4*)(w8 + k * 8 + 4); }
        int m = gw;
        if (m < M) { P1_LOAD(xq, m); const int m1 = m + NGW < M ? m + NGW : m; P1_LOAD(xn, m1); }
        for (; m < M; m += NGW) {
            const int b = m >> 13;
            if (b != bcur) { bcur = b; const float* md = MOD + b * 6144;
#pragma unroll
                for (int c = 0; c < 2; ++c)
#pragma unroll
                    for (int j = 0; j < 8; ++j) { const int k = c * 512 + lane * 8 + j; gq[c * 8 + j] = nm[k] * (1.f + md[1024 + k]); sq[c * 8 + j] = md[k]; } }
            float v[16]; float ss = 0.f;
#pragma unroll
            for (int i = 0; i < 4; ++i)
#pragma unroll
                for (int j = 0; j < 4; ++j) { v[i * 4 + j] = xq[i][j]; ss += xq[i][j] * xq[i][j]; }
#pragma unroll
            for (int i = 0; i < 4; ++i) xq[i] = xn[i];
            { const int mn = m + 2 * NGW < M ? m + 2 * NGW : m; P1_LOAD(xn, mn); }
            const float rstd = rsqrtf(wave_sum(ss) * (1.f / D) + EPS);
            float hh[16]; float d8[8] = {0.f, 0.f, 0.f, 0.f, 0.f, 0.f, 0.f, 0.f};
#pragma unroll
            for (int c = 0; c < 2; ++c) {
#pragma unroll
                for (int j = 0; j < 8; ++j) { const int k = c * 512 + lane * 8 + j;
                    const float hv = v[c * 8 + j] * rstd * gq[c * 8 + j] + sq[c * 8 + j]; hh[c * 8 + j] = hv;
                    const f32x4 wa = wreg[c * 8 + j][0], wb = wreg[c * 8 + j][1];
                    d8[0] += hv * wa[0]; d8[1] += hv * wa[1]; d8[2] += hv * wa[2]; d8[3] += hv * wa[3]; d8[4] += hv * wb[0]; d8[5] += hv * wb[1]; d8[6] += hv * wb[2]; d8[7] += hv * wb[3]; }
                v4u o; o.x = pk2(hh[c * 8 + 0], hh[c * 8 + 1]); o.y = pk2(hh[c * 8 + 2], hh[c * 8 + 3]); o.z = pk2(hh[c * 8 + 4], hh[c * 8 + 5]); o.w = pk2(hh[c * 8 + 6], hh[c * 8 + 7]);
                *(v4u*)(H + (size_t)m * D + c * 512 + lane * 8) = o; }
#pragma unroll
            for (int j = 0; j < 4; ++j) { const bool up = (lane & 32) != 0; const float send = up ? d8[j] : d8[j + 4]; const float keep = up ? d8[j + 4] : d8[j]; d8[j] = keep + __shfl_xor(send, 32); }
#pragma unroll
            for (int j = 0; j < 2; ++j) { const bool up = (lane & 16) != 0; const float send = up ? d8[j] : d8[j + 2]; const float keep = up ? d8[j + 2] : d8[j]; d8[j] = keep + __shfl_xor(send, 16); }
            { const bool up = (lane & 8) != 0; const float send = up ? d8[0] : d8[1]; const float keep = up ? d8[1] : d8[0]; d8[0] = keep + __shfl_xor(send, 8); }
            float dv = d8[0]; dv += __shfl_xor(dv, 4); dv += __shfl_xor(dv, 2); dv += __shfl_xor(dv, 1);
            if ((lane & 7) == 0) BA[(size_t)m * 8 + (lane >> 3)] = dv;
        }
#undef P1_LOAD
        __syncthreads();
    }
    SEAM(1); }

    for (int rep_ = 0; rep_ < NREP(2); ++rep_) { if (IN(2)) {
        PHASE_PTRS
        SchedDense S{(const char*)H, (const char*)(ws + WS_WIN), M / 256, NPROJ / 256, G, bid, D};
        EpiProj E{PROJ};
        pg8::gemm_phase<EpiProj, SchedDense, true>((LAS unsigned char*)lds, D, S, E, tid);
    }
    SEAM(2); }

    for (int rep_ = 0; rep_ < NREP(3); ++rep_) { if (IN(3)) {
        PHASE_PTRS
        gdn_prep_items(lds, ws, PROJ, BA, ap->in[I_GCONV], ap->in[I_GALOG], ap->in[I_GDT], 0, vcu, G, NSPLIT / 16);
        if (N_LAUNCHES == 1) {
            __syncthreads();
            if (tid == 0) __hip_atomic_fetch_add(ctl + CW_P3, 1u, RLX_AGENT);
        }
    }
    if (N_LAUNCHES != 1) SEAM(3); }

    for (int rep_ = 0; rep_ < NREP(4); ++rep_) { if (IN(4)) {
        PHASE_PTRS
        constexpr int NSCAN = 32;
        const bool xmap = (G % 8 == 0) && G >= 64;
        const bool is_scan = xmap ? (bid < NSCAN) : (vcu < NSCAN);
        const int sj_ = xmap ? (bid >> 3) : (vcu >> 4) * 2 + ((vcu >> 3) & 1);
        const int sbh = xmap ? (((bid & 7) << 1) | (sj_ & 1)) : (vcu & 15), shf = xmap ? (sj_ >> 1) : (vcu >> 4);
        const int vbn = xmap ? bid - NSCAN : vcu - NSCAN, nbn = G - NSCAN;
        if (is_scan) { for (int rs4_ = 0; rs4_ < ((PROBE_SUB & 4) ? 2 : 1); ++rs4_) {
            const int bh = sbh, hf = shf, b = bh >> 2, h = bh & 3;
            const unsigned char* gblob = ws + WS_GBLOB + (size_t)bh * 128 * 57344;
            const unsigned char* gub = ws + WS_GU + (size_t)bh * 128 * 16384;
            LAS unsigned char* L = (LAS unsigned char*)lds;
            constexpr int STEPB = 73728;
            if (wave >= 4) {
                const int lw = wave - 4;
#define RING_ISSUE(nn__, ty_) do { int n_ = (nn__); const int bo_ = (n_ & 1) * STEPB; n_ = n_ < 128 ? n_ : 127; \
                    const unsigned char* src_ = ((ty_) == 0) ? gub + (size_t)n_ * 16384 : gblob + (size_t)n_ * 57344 + ((ty_) == 1 ? 0 : (ty_) == 2 ? 16384 : (ty_) == 3 ? 32768 : 40960); \
                    LAS unsigned char* dst_ = L + bo_ + ((ty_) == 0 ? 0 : (ty_) == 1 ? 16384 : (ty_) == 2 ? 32768 : (ty_) == 3 ? 49152 : 57344); const int nq_ = ((ty_) == 3 || (ty_) == 0) ? 2 : 4; \
                    for (int q_ = 0; q_ < nq_; ++q_) { const int blk_ = ((ty_) == 0 ? 8 * hf : 0) + lw + 4 * q_;     __builtin_amdgcn_global_load_lds((const unsigned*)(src_ + blk_ * 1024 + lane * 16), (LAS unsigned*)(dst_ + blk_ * 1024), 16, 0, 0); } } while (0)
#define RING_BAR(nv_) do { asm volatile("s_waitcnt vmcnt(" #nv_ ")" ::: "memory"); __builtin_amdgcn_s_barrier(); asm volatile("" ::: "memory"); } while (0)
                if (N_LAUNCHES == 1 && NSPLIT > 0) { const unsigned want = (unsigned)G * (unsigned)(rep_ + 1); unsigned sp = 0;
                    while (__hip_atomic_load(ctl + CW_P3, RLX_AGENT) < want) { __builtin_amdgcn_s_sleep(2); if (++sp > (1u << 22)) break; }
                    __builtin_amdgcn_fence(__ATOMIC_ACQUIRE, "agent"); asm volatile("s_waitcnt vmcnt(0)" ::: "memory"); }
                RING_ISSUE(0, 0); RING_ISSUE(0, 1); RING_ISSUE(0, 2); RING_ISSUE(0, 3); RING_ISSUE(0, 4); RING_ISSUE(1, 0); RING_ISSUE(1, 1); RING_ISSUE(1, 2); RING_ISSUE(1, 3);
                for (int n = 0; n < 128; ++n) {
                    if (n >= NSPLIT - 2 && n + 2 < 128 && (n + 2 == NSPLIT || (n + 2 - NSPLIT >= SG0 && ((n + 2 - NSPLIT - SG0) % SGC) == 0))) {
                        const int s_ = gdn_stage_of(n + 2 - NSPLIT);
                        const unsigned want = (unsigned)nbn * (unsigned)(rep_ + 1); unsigned sp = 0;
                        while (__hip_atomic_load(ctl + CW_GDN2 + s_, RLX_AGENT) < want) { __builtin_amdgcn_s_sleep(2); if (++sp > (1u << 22)) break; }
                        __builtin_amdgcn_fence(__ATOMIC_ACQUIRE, "agent"); asm volatile("s_waitcnt vmcnt(0)" ::: "memory"); }
                    RING_BAR(22); RING_ISSUE(n + 1, 4);
                    RING_BAR(22); RING_ISSUE(n + 2, 0); RING_ISSUE(n + 2, 1);
                    RING_BAR(26); RING_ISSUE(n + 2, 2);
                    RING_BAR(26); RING_ISSUE(n + 2, 3);
                }
                asm volatile("s_waitcnt vmcnt(0)" ::: "memory");
#undef RING_ISSUE
#undef RING_BAR
            } else if (wave >= 2) {
                for (int n = 0; n < 128; ++n) { __builtin_amdgcn_s_barrier(); __builtin_amdgcn_s_barrier(); __builtin_amdgcn_s_barrier(); __builtin_amdgcn_s_barrier(); }
            } else {
                const int sl = 2 * hf + wave, c = lane & 31, hh = lane >> 5;
                f32x16 S[4];
#pragma unroll
                for (int i = 0; i < 4; ++i)
#pragma unroll
                    for (int r = 0; r < 16; ++r) S[i][r] = 0.f;
                bf16* og = OGDN + ((size_t)b * SEQ) * 1024 + h * 128 + 32 * sl + c;
#define CBAR() do { asm volatile("" ::: "memory"); __builtin_amdgcn_s_barrier(); asm volatile("" ::: "memory"); } while (0)
#define AFR(base, blk) (*(const LAS pg8::bf16x8*)((base) + (blk) * 1024))
                for (int n = 0; n < 128; ++n) {
                    const LAS unsigned char* sb_ = L + (n & 1) * STEPB;
                    const LAS unsigned char* pU = sb_ + ((sl * 2) * 64 + lane) * 32;
                    const LAS unsigned char* pW = sb_ + 16384 + lane * 16;
                    const LAS unsigned char* pQ = sb_ + 32768 + lane * 16;
                    const LAS unsigned char* pK = sb_ + 49152 + lane * 16;
                    const LAS unsigned char* pD = sb_ + 57344 + lane * 16;
                    pg8::bf16x8 Sb[4][2];
#pragma unroll
                    for (int i = 0; i < 4; ++i)
#pragma unroll
                        for (int t = 0; t < 2; ++t) { v4u p; p.x = pkbf(S[i][8 * t], S[i][8 * t + 1]); p.y = pkbf(S[i][8 * t + 2], S[i][8 * t + 3]); p.z = pkbf(S[i][8 * t + 4], S[i][8 * t + 5]); p.w = pkbf(S[i][8 * t + 6], S[i][8 * t + 7]); Sb[i][t] = __builtin_bit_cast(pg8::bf16x8, p); }
                    CBAR();
                    f32x16 vn[2];
#pragma unroll
                    for (int a = 0; a < 2; ++a) { const v4u w0 = *(const LAS v4u*)(pU + a * 2048), w1 = *(const LAS v4u*)(pU + a * 2048 + 16);
                        vn[a][0] = bflo(w0.x); vn[a][1] = bfhi(w0.x); vn[a][2] = bflo(w0.y); vn[a][3] = bfhi(w0.y); vn[a][4] = bflo(w0.z); vn[a][5] = bfhi(w0.z); vn[a][6] = bflo(w0.w); vn[a][7] = bfhi(w0.w);
                        vn[a][8] = bflo(w1.x); vn[a][9] = bfhi(w1.x); vn[a][10] = bflo(w1.y); vn[a][11] = bfhi(w1.y); vn[a][12] = bflo(w1.z); vn[a][13] = bfhi(w1.z); vn[a][14] = bflo(w1.w); vn[a][15] = bfhi(w1.w); }
#pragma unroll
                    for (int a = 0; a < 2; ++a)
#pragma unroll
                        for (int kq = 0; kq < 8; ++kq) vn[a] = __builtin_amdgcn_mfma_f32_32x32x16_bf16(AFR(pW, a * 8 + kq), Sb[kq >> 1][kq & 1], vn[a], 0, 0, 0);
                    CBAR();
                    f32x16 o[2];
#pragma unroll
                    for (int a = 0; a < 2; ++a)
#pragma unroll
                        for (int r = 0; r < 16; ++r) o[a][r] = 0.f;
#pragma unroll
                    for (int a = 0; a < 2; ++a)
#pragma unroll
                        for (int kq = 0; kq < 8; ++kq) o[a] = __builtin_amdgcn_mfma_f32_32x32x16_bf16(AFR(pQ, a * 8 + kq), Sb[kq >> 1][kq & 1], o[a], 0, 0, 0);
                    pg8::bf16x8 Vb[2][2];
#pragma unroll
                    for (int a = 0; a < 2; ++a)
#pragma unroll
                        for (int t = 0; t < 2; ++t) { v4u p; p.x = pkbf(vn[a][8 * t], vn[a][8 * t + 1]); p.y = pkbf(vn[a][8 * t + 2], vn[a][8 * t + 3]); p.z = pkbf(vn[a][8 * t + 4], vn[a][8 * t + 5]); p.w = pkbf(vn[a][8 * t + 6], vn[a][8 * t + 7]); Vb[a][t] = __builtin_bit_cast(pg8::bf16x8, p); }
                    CBAR();
                    const float glc = *(const LAS float*)(sb_ + 49152 + 2048);
#pragma unroll
                    for (int kq = 0; kq < 2; ++kq) o[0] = __builtin_amdgcn_mfma_f32_32x32x16_bf16(AFR(pK, kq), Vb[kq >> 1][kq & 1], o[0], 0, 0, 0);
#pragma unroll
                    for (int kq = 0; kq < 4; ++kq) o[1] = __builtin_amdgcn_mfma_f32_32x32x16_bf16(AFR(pK, 4 + kq), Vb[kq >> 1][kq & 1], o[1], 0, 0, 0);
#pragma unroll
                    for (int i = 0; i < 4; ++i)
#pragma unroll
                        for (int r = 0; r < 16; ++r) S[i][r] *= glc;
                    CBAR();
#pragma unroll
                    for (int i = 0; i < 4; ++i)
#pragma unroll
                        for (int kq = 0; kq < 4; ++kq) S[i] = __builtin_amdgcn_mfma_f32_32x32x16_bf16(AFR(pD, i * 4 + kq), Vb[kq >> 1][kq & 1], S[i], 0, 0, 0);
                    bf16* on = og + (size_t)(n * 64) * 1024;
#pragma unroll
                    for (int a = 0; a < 2; ++a)
#pragma unroll
                        for (int r = 0; r < 16; ++r) on[(size_t)(32 * a + (r & 3) + 8 * (r >> 2) + 4 * hh) * 1024] = (bf16)(pkbf(o[a][r], 0.f) & 0xffffu);
                }
#undef AFR
#undef CBAR
            }
            if (PROBE_SUB & 4) __syncthreads(); }
            if (N_LAUNCHES == 1) {
                asm volatile("s_waitcnt vmcnt(0)" ::: "memory");
                __syncthreads();
                if (tid == 0) { __builtin_amdgcn_fence(__ATOMIC_RELEASE, "agent"); asm volatile("s_waitcnt vmcnt(0)" ::: "memory"); __hip_atomic_fetch_add(ctl + CW_SCAN, 1u, RLX_AGENT); }
            }
        } else {
            {
                const int vb0 = vbn, nb0 = nbn; constexpr int NIT2 = 16 * (128 - NSPLIT); const int cnt1 = vb0 < NIT2 ? (NIT2 - vb0 + nb0 - 1) / nb0 : 0;
                static_assert(NSTG == 1 + (128 - NSPLIT - SG0 + SGC - 1) / SGC && NSTG <= 8, "stage count");
                gdn_prep_items(lds, ws, PROJ, BA, ap->in[I_GCONV], ap->in[I_GALOG], ap->in[I_GDT], 1, vb0, nb0, cnt1, ctl);
                asm volatile("s_waitcnt vmcnt(0)" ::: "memory");
                __syncthreads();
                if (tid == 0) {
                    const int s0_ = cnt1 > 0 ? gdn_stage_of((vb0 + nb0 * (cnt1 - 1)) >> 4) : 0;
                    for (int s_ = s0_; s_ < NSTG; ++s_) __hip_atomic_fetch_add(ctl + CW_GDN2 + s_, 1u, RLX_AGENT); }
            }
            const bool tr_first = (vbn & 1) != 0;
            if (tr_first) {
            {
                LAS unsigned char* Tl = (LAS unsigned char*)lds + wave * 16384;
                constexpr int IT_1 = 16 * 32, IT_2 = 16 * 16, NITM = NE * (IT_1 + IT_2);
                const int gw2 = vbn * NWAVES + wave, NGW2 = nbn * NWAVES;
                const float* w1p = ap->in[I_W1]; const float* w2p = ap->in[I_W2]; bf16* W1T = (bf16*)(ws + WS_W1); bf16* W2T = (bf16*)(ws + WS_W2);
#define MOE_TR_ITEM(t_, it_) do { const int i_ = (it_); if (i_ < NE * IT_1) { const int e_ = i_ / IT_1, r_ = i_ % IT_1; t_ = TrItem{w1p + (size_t)e_ * D * 2048, W1T + (size_t)e_ * 2048 * D, 2048, D, 64 * (r_ / 32), 64 * (r_ % 32)}; } \
                    else { const int q_ = i_ - NE * IT_1, e_ = q_ / IT_2, r_ = q_ % IT_2; t_ = TrItem{w2p + (size_t)e_ * FF * D, W2T + (size_t)e_ * D * FF, D, FF, 64 * (r_ / 16), 64 * (r_ % 16)}; } } while (0)
                for (int rs8_ = 0; rs8_ < ((PROBE_SUB & 8) ? 2 : 1); ++rs8_) {
                    f32x4 va[16], vb[16]; TrItem ta, tb;
                    { MOE_TR_ITEM(ta, gw2); tr64_load(ta, va, lane); }
                    for (int it = gw2; it < NITM; it += 2 * NGW2) {
                        { const int ib = it + NGW2 < NITM ? it + NGW2 : NITM - 1; MOE_TR_ITEM(tb, ib); tr64_load(tb, vb, lane); }
                        tr64_finish(ta, va, Tl, lane);
                        { const int ia = it + 2 * NGW2 < NITM ? it + 2 * NGW2 : NITM - 1; MOE_TR_ITEM(ta, ia); tr64_load(ta, va, lane); }
                        tr64_finish(tb, vb, Tl, lane);
                    }
                }
#undef MOE_TR_ITEM
            }
            __syncthreads();
            }
        {
            bf16* RAW = (bf16*)lds;
            float* XCf = (float*)(lds + 17408);
            bf16* XCb = (bf16*)(lds + 50176);
            bf16* WAT = (bf16*)(lds + 68608);
            bf16* WXT = (bf16*)(lds + 77824);
            float* AA = (float*)(lds + 87040);
            float* GE = (float*)(lds + 119808);
            const int c = tid & 63, tg = tid >> 6; const int vb = vbn, GB = nbn; const int nfix = vb & 7;
            {
                for (int i = tid; i < 4096; i += NTHR) { const int cc = i >> 6, d = i & 63;
                    WAT[d * 72 + cc] = (bf16)f2bf(ap->in[I_LWA][(size_t)nfix * 4096 + i]); WXT[d * 72 + cc] = (bf16)f2bf(ap->in[I_LWX][(size_t)nfix * 4096 + i]); }
            }
            const int mt = wave >> 1, nt = wave & 1, r32 = lane & 31, hh = lane >> 5;
            const int dch = nfix * 64 + 32 * nt + r32;
            const float ba_ = ap->in[I_LBA][dch], bx_ = ap->in[I_LBX][dch], sp_ = softplusf_(-ap->in[I_LLAM][dch]);
            const int chc = nfix * 64 + c;
            const float w0 = ap->in[I_LCONVW][chc], w1 = ap->in[I_LCONVW][512 + chc], w2 = ap->in[I_LCONVW][1024 + chc], w3 = ap->in[I_LCONVW][1536 + chc], cb = ap->in[I_LCONVB][chc];
            v4u praw[3];
#define LRU_PREFETCH(tile_) do { const int ck_ = ((tile_) >> 3) % NLCH, b_ = (tile_) / (8 * NLCH); const size_t mm_ = (size_t)b_ * SEQ + ck_ * LCH; \
                _Pragma("unroll") for (int i_ = 0; i_ < 3; ++i_) { const int q_ = tid + 512 * i_, row_ = q_ >> 3, c8_ = q_ & 7; praw[i_] = (v4u){0u, 0u, 0u, 0u}; \
                    if (q_ < 1048 && ck_ * LCH - 3 + row_ >= 0) praw[i_] = *(const v4u*)(PROJ + (mm_ - 3 + row_) * NPROJ + C_XB + nfix * 64 + c8_ * 8); } } while (0)
            for (int rs_ = 0; rs_ < ((PROBE_SUB & 2) ? 2 : 1); ++rs_) {
            int tile = vb;
            if (tile < BATCH * NLCH * 8) LRU_PREFETCH(tile);
            for (; tile < BATCH * NLCH * 8; tile += GB) {
                const int ck = (tile >> 3) % NLCH, b = tile / (8 * NLCH);
                const int ch = nfix * 64 + c, t0 = ck * LCH + tg * 16; const size_t m0 = (size_t)b * SEQ + t0;
#pragma unroll
                for (int i = 0; i < 3; ++i) { const int q = tid + 512 * i; if (q < 1048) *(v4u*)(RAW + q * 8) = praw[i]; }
                __syncthreads();
                if (tile + GB < BATCH * NLCH * 8) LRU_PREFETCH(tile + GB);
                {
                    float win[19];
#pragma unroll
                    for (int j = 0; j < 19; ++j) win[j] = bf1(RAW[(tg * 16 + j) * 64 + c]);
#pragma unroll
                    for (int j = 0; j < 16; ++j) { const float xc = w0 * win[j] + w1 * win[j + 1] + w2 * win[j + 2] + w3 * win[j + 3] + cb;
                        XCf[(tg * 16 + j) * 64 + c] = xc; XCb[(tg * 16 + j) * 72 + c] = (bf16)f2bf(xc); }
                }
                __syncthreads();
                {
                    f32x16 aR, aI;
#pragma unroll
                    for (int i = 0; i < 16; ++i) { aR[i] = 0.f; aI[i] = 0.f; }
#pragma unroll
                    for (int kk = 0; kk < 4; ++kk) { const pg8::bf16x8 af = *(const pg8::bf16x8*)(XCb + (32 * mt + r32) * 72 + 16 * kk + 8 * hh);
                        const pg8::bf16x8 bA = *(const pg8::bf16x8*)(WAT + (32 * nt + r32) * 72 + 16 * kk + 8 * hh), bX = *(const pg8::bf16x8*)(WXT + (32 * nt + r32) * 72 + 16 * kk + 8 * hh);
                        aR = __builtin_amdgcn_mfma_f32_32x32x16_bf16(af, bA, aR, 0, 0, 0); aI = __builtin_amdgcn_mfma_f32_32x32x16_bf16(af, bX, aI, 0, 0, 0); }
#pragma unroll
                    for (int reg = 0; reg < 16; ++reg) { const int tok = 32 * mt + (reg & 3) + 8 * (reg >> 2) + 4 * hh, d = 32 * nt + r32;
                        const float r = sigmoidf_(aR[reg] + ba_), ig = sigmoidf_(aI[reg] + bx_);
                        const float la = -8.f * r * sp_, a = __expf(la), mult = __builtin_amdgcn_sqrtf(fmaxf(1.f - a * a, 0.f));
                        const float xc = XCf[tok * 64 + d]; XCf[tok * 64 + d] = mult * ig * xc; AA[tok * 64 + d] = a; }
                }
                __syncthreads();
                {
                    float hl = 0.f, pl = 1.f;
#pragma unroll
                    for (int j = 0; j < 16; ++j) { const float a = AA[(tg * 16 + j) * 64 + c], bt = XCf[(tg * 16 + j) * 64 + c]; hl = a * hl + bt; pl *= a; }
                    GE[(tg * 64 + c) * 2] = pl; GE[(tg * 64 + c) * 2 + 1] = hl;
                }
                __syncthreads();
                {
                    float hc = 0.f, pc = 1.f;
                    for (int g = 0; g < tg; ++g) { const float pg = GE[(g * 64 + c) * 2], hg = GE[(g * 64 + c) * 2 + 1]; hc = pg * hc + hg; pc *= pg; }
                    float h = hc, p = pc;
#pragma unroll
                    for (int j = 0; j < 16; ++j) { const float a = AA[(tg * 16 + j) * 64 + c], bt = XCf[(tg * 16 + j) * 64 + c]; h = a * h + bt; p *= a;
                        HLOC[(m0 + j) * 512 + ch] = (bf16)f2bf(h); PLOC[(m0 + j) * 512 + ch] = (bf16)f2bf(p); }
                    if (tg == 7) { LEND[(size_t)((b * NLCH + ck) * 512 + ch)] = p; LEND[(size_t)BATCH * NLCH * 512 + (size_t)((b * NLCH + ck) * 512 + ch)] = h; }
                }
            }
            __syncthreads();
            }
#undef LRU_PREFETCH
        }
            {
                asm volatile("s_waitcnt vmcnt(0)" ::: "memory");
                __syncthreads();
                if (tid == 0) { __builtin_amdgcn_fence(__ATOMIC_RELEASE, "agent"); asm volatile("s_waitcnt vmcnt(0)" ::: "memory"); __hip_atomic_fetch_add(ctl + CW_LRU, 1u, RLX_AGENT); }
            }
            if (!tr_first) {
            __syncthreads();
            {
                LAS unsigned char* Tl = (LAS unsigned char*)lds + wave * 16384;
                constexpr int IT_1 = 16 * 32, IT_2 = 16 * 16, NITM = NE * (IT_1 + IT_2);
                const int gw2 = vbn * NWAVES + wave, NGW2 = nbn * NWAVES;
                const float* w1p = ap->in[I_W1]; const float* w2p = ap->in[I_W2]; bf16* W1T = (bf16*)(ws + WS_W1); bf16* W2T = (bf16*)(ws + WS_W2);
#define MOE_TR_ITEM(t_, it_) do { const int i_ = (it_); if (i_ < NE * IT_1) { const int e_ = i_ / IT_1, r_ = i_ % IT_1; t_ = TrItem{w1p + (size_t)e_ * D * 2048, W1T + (size_t)e_ * 2048 * D, 2048, D, 64 * (r_ / 32), 64 * (r_ % 32)}; } \
                    else { const int q_ = i_ - NE * IT_1, e_ = q_ / IT_2, r_ = q_ % IT_2; t_ = TrItem{w2p + (size_t)e_ * FF * D, W2T + (size_t)e_ * D * FF, D, FF, 64 * (r_ / 16), 64 * (r_ % 16)}; } } while (0)
                for (int rs8_ = 0; rs8_ < ((PROBE_SUB & 8) ? 2 : 1); ++rs8_) {
                    f32x4 va[16], vb[16]; TrItem ta, tb;
                    { MOE_TR_ITEM(ta, gw2); tr64_load(ta, va, lane); }
                    for (int it = gw2; it < NITM; it += 2 * NGW2) {
                        { const int ib = it + NGW2 < NITM ? it + NGW2 : NITM - 1; MOE_TR_ITEM(tb, ib); tr64_load(tb, vb, lane); }
                        tr64_finish(ta, va, Tl, lane);
                        { const int ia = it + 2 * NGW2 < NITM ? it + 2 * NGW2 : NITM - 1; MOE_TR_ITEM(ta, ia); tr64_load(ta, va, lane); }
                        tr64_finish(tb, vb, Tl, lane);
                    }
                }
#undef MOE_TR_ITEM
            }
            }
            {
                if (tid == 0) { const unsigned want = (unsigned)nbn * (unsigned)(rep_ + 1); unsigned sp = 0;
                    while (__hip_atomic_load(ctl + CW_LRU, RLX_AGENT) < want) { __builtin_amdgcn_s_sleep(2); if (++sp > (1u << 22)) break; }
                    __builtin_amdgcn_fence(__ATOMIC_ACQUIRE, "agent"); asm volatile("s_waitcnt vmcnt(0)" ::: "memory"); }
                __syncthreads();
            }
            {
            const int c = tid & 63, tg = tid >> 6; float* CI = (float*)lds;
            const int tk = tid >> 2, c16 = (tid & 3) * 16;
            float pvn[8], hvn[8]; v4u hn0, hn1, pn0, pn1, yn0, yn1;
#define LRUF_PREFETCH(tile_) do { const int n_ = (tile_) & 7, ck_ = ((tile_) >> 3) % NLCH, b_ = (tile_) / (8 * NLCH); const int ch_ = n_ * 64 + c; \
                const float* pe_ = LEND + (size_t)(b_ * NLCH) * 512 + ch_; const float* he_ = pe_ + (size_t)BATCH * NLCH * 512; \
                _Pragma("unroll") for (int q = 0; q < 8; ++q) { const int k2 = tg * 8 + q; const bool ok = k2 < ck_; pvn[q] = ok ? pe_[(size_t)k2 * 512] : 1.f; hvn[q] = ok ? he_[(size_t)k2 * 512] : 0.f; } \
                const size_t m_ = (size_t)b_ * SEQ + ck_ * LCH + tk; const int chb_ = n_ * 64 + c16; \
                hn0 = *(const v4u*)(HLOC + m_ * 512 + chb_); hn1 = *(const v4u*)(HLOC + m_ * 512 + chb_ + 8); pn0 = *(const v4u*)(PLOC + m_ * 512 + chb_); pn1 = *(const v4u*)(PLOC + m_ * 512 + chb_ + 8); \
                yn0 = *(const v4u*)(PROJ + m_ * NPROJ + C_YB + chb_); yn1 = *(const v4u*)(PROJ + m_ * NPROJ + C_YB + chb_ + 8); } while (0)
            int tile = vbn;
            if (tile < BATCH * NLCH * 8) LRUF_PREFETCH(tile);
            for (; tile < BATCH * NLCH * 8; tile += nbn) {
                const int n = tile & 7, ck = (tile >> 3) % NLCH, b = tile / (8 * NLCH);
                float pv[8], hv[8];
#pragma unroll
                for (int q = 0; q < 8; ++q) { pv[q] = pvn[q]; hv[q] = hvn[q]; }
                const v4u h0 = hn0, h1 = hn1, p0 = pn0, p1 = pn1, y0 = yn0, y1 = yn1;
                { const int tn = tile + nbn < BATCH * NLCH * 8 ? tile + nbn : tile; LRUF_PREFETCH(tn); }
                {
                    float ps = 1.f, hs = 0.f;
#pragma unroll
                    for (int q = 0; q < 8; ++q) { hs = pv[q] * hs + hv[q]; ps *= pv[q]; }
                    CI[(tg * 64 + c) * 2] = ps; CI[(tg * 64 + c) * 2 + 1] = hs;
                }
                LBAR();
                float cin = 0.f;
#pragma unroll
                for (int g2 = 0; g2 < 8; ++g2) cin = CI[(g2 * 64 + c) * 2] * cin + CI[(g2 * 64 + c) * 2 + 1];
                CI[1024 + tg * 64 + c] = cin;
                LBAR();
                {
                    const size_t m = (size_t)b * SEQ + ck * LCH + tk; const int chb = n * 64 + c16;
                    const unsigned hw_[8] = {h0.x, h0.y, h0.z, h0.w, h1.x, h1.y, h1.z, h1.w}, pw_[8] = {p0.x, p0.y, p0.z, p0.w, p1.x, p1.y, p1.z, p1.w}, yw_[8] = {y0.x, y0.y, y0.z, y0.w, y1.x, y1.y, y1.z, y1.w};
                    unsigned ow_[8];
#pragma unroll
                    for (int q = 0; q < 8; ++q) { const float ci0 = CI[1024 + c16 + 2 * q], ci1 = CI[1024 + c16 + 2 * q + 1];
                        const float a0 = bflo(hw_[q]) + bflo(pw_[q]) * ci0, a1 = bfhi(hw_[q]) + bfhi(pw_[q]) * ci1; const float yb0 = bflo(yw_[q]), yb1 = bfhi(yw_[q]);
                        const float g0 = gelu_tanh_(yb0), g1 = gelu_tanh_(yb1);
                        ow_[q] = pkbf(a0 * g0, a1 * g1); }
                    *(v4u*)(OLRU + m * 1024 + chb) = (v4u){ow_[0], ow_[1], ow_[2], ow_[3]}; *(v4u*)(OLRU + m * 1024 + chb + 8) = (v4u){ow_[4], ow_[5], ow_[6], ow_[7]};
                }
                LBAR();
            }
#undef LRUF_PREFETCH
            }
        }
    }
    if (N_LAUNCHES != 1) SEAM(4); }

    for (int rep_ = 0; rep_ < NREP(5); ++rep_) { if (IN(5)) {
        PHASE_PTRS
        if (N_LAUNCHES == 1) {
            if (tid == 0) { const unsigned want = 32u * (unsigned)(rep_ + 1); unsigned sp = 0;
                while (__hip_atomic_load(ctl + CW_SCAN, RLX_AGENT) < want) { __builtin_amdgcn_s_sleep(2); if (++sp > (1u << 22)) break; }
                __builtin_amdgcn_fence(__ATOMIC_ACQUIRE, "agent"); asm volatile("s_waitcnt vmcnt(0)" ::: "memory"); }
            __syncthreads();
        }
        const float* nw = ap->in[I_GNORM]; const float nw0 = nw[2 * lane], nw1 = nw[2 * lane + 1];
        unsigned oq[4], zq[4];
#define P5_LOAD(m_) do { _Pragma("unroll") for (int h_ = 0; h_ < 4; ++h_) { oq[h_] = *(const unsigned*)(OGDN + (size_t)(m_) * 1024 + h_ * 128 + 2 * lane); zq[h_] = *(const unsigned*)(PROJ + (size_t)(m_) * NPROJ + C_Z + h_ * 128 + 2 * lane); } } while (0)
        int m = gw;
        if (m < M) P5_LOAD(m);
        for (; m < M; m += NGW) {
            unsigned ow[4], zw[4];
#pragma unroll
            for (int h = 0; h < 4; ++h) { ow[h] = oq[h]; zw[h] = zq[h]; }
            { const int mn = m + NGW < M ? m + NGW : m; P5_LOAD(mn); }
#pragma unroll
            for (int h = 0; h < 4; ++h) { const float o0 = bflo(ow[h]), o1 = bfhi(ow[h]);
                const float sc = rsqrtf(wave_sum(o0 * o0 + o1 * o1) * (1.f / 128.f) + EPS);
                *(unsigned*)(OGDN + (size_t)m * 1024 + h * 128 + 2 * lane) = pk2(o0 * sc * nw0 * siluf_(bflo(zw[h])), o1 * sc * nw1 * siluf_(bfhi(zw[h]))); }
        }
#undef P5_LOAD
    }
    SEAM(5); if (PROBE_SUB & 16) { for (int q_ = 0; q_ < 8; ++q_) xcd_barrier(bar); } }

    for (int rep_ = 0; rep_ < NREP(6); ++rep_) { if (IN(6)) {
        PHASE_PTRS
        SchedDense S{(const char*)OGDN, (const char*)(ws + WS_WBG), M / 256, D / 256, G, bid, D};
        EpiBranch E{MERGED, PROJ};
        pg8::gemm_phase<EpiBranch, SchedDense, true>((LAS unsigned char*)lds, D, S, E, tid);
    }
    SEAM(6); }

    for (int rep_ = 0; rep_ < NREP(7); ++rep_) { if (IN(7)) {
        PHASE_PTRS
        SchedDense S{(const char*)MERGED, (const char*)(ws + WS_WOUT), M / 256, D / 256, G, bid, D};
        EpiOut E{X2, x, MOD};
        pg8::gemm_phase<EpiOut, SchedDense, true>((LAS unsigned char*)lds, D, S, E, tid);
    }
    SEAM(7); }

    for (int rep_ = 0; rep_ < NREP(8); ++rep_) { if (IN(8)) {
        PHASE_PTRS
        if (NREP(8) > 1 && rep_ == 1) { if (bid == 0 && tid < 32) __hip_atomic_store(CNT + tid, 0u, RLX_AGENT); xcd_barrier(bar); }
        constexpr int TP = 2064, TBY = 32 * TP;
        LAS unsigned char* TB = (LAS unsigned char*)lds;
        float* RS = (float*)(lds + 2 * TBY);
        int* lcnt = (int*)(lds + AUX_OFF);
        int* lbase = lcnt + 32;
        int* lent = lbase + 32;
        const bf16* WGH = (const bf16*)(ws + WS_WGH); const bf16* WGL = (const bf16*)(ws + WS_WGL); const float* CB = (const float*)(ws + WS_CB);
#define P8_DMA(g_, buf_) do { const bf16* src_ = X2 + (size_t)(rb * 128 + (g_) * 32) * D; \
            for (int q_ = 0; q_ < 8; ++q_) { const int p_ = wave + 8 * q_; \
                __builtin_amdgcn_global_load_lds((const unsigned*)(src_ + (size_t)(p_ >> 1) * D + (p_ & 1) * 512 + lane * 8), (LAS unsigned*)(TB + (buf_) * TBY + (p_ >> 1) * TP + (p_ & 1) * 1024), 16, 0, 0); } } while (0)
        for (int rb = vcu; rb < M / 128; rb += G) {
            const int b = (rb * 128) >> 13; const float* md = MOD + b * 6144; const float* nf = ap->in[I_NFFN];
            if (tid < 32) lcnt[tid] = 0;
            P8_DMA(0, 0);
            float gq[8], sq[8];
#pragma unroll
            for (int j = 0; j < 8; ++j) { const int k = 128 * wave + 8 * (lane & 15) + j; gq[j] = nf[k] * (1.f + md[4096 + k]); sq[j] = md[3072 + k]; }
            pg8::bf16x8 wh[8], wl[8];
            { const int r32 = lane & 31, hh = lane >> 5;
#pragma unroll
                for (int st = 0; st < 8; ++st) { const size_t wo = ((size_t)(b * 32 + r32)) * 1024 + 128 * wave + 16 * st + 8 * hh; wh[st] = *(const pg8::bf16x8*)(WGH + wo); wl[st] = *(const pg8::bf16x8*)(WGL + wo); } }
            asm volatile("s_waitcnt vmcnt(0)" ::: "memory");
            LBAR();
            for (int grp = 0; grp < 4; ++grp) {
                const int m0 = rb * 128 + grp * 32;
                LAS unsigned char* T = TB + (grp & 1) * TBY;
                if (grp + 1 < 4) P8_DMA(grp + 1, (grp + 1) & 1);
                {
                    const int row = tid >> 4, cl = tid & 15; float ss = 0.f;
#pragma unroll
                    for (int i = 0; i < 8; ++i) { const v4u q = *(const LAS v4u*)(T + row * TP + (cl + 16 * i) * 16);
                        const float t0 = bflo(q.x), t1 = bfhi(q.x), t2 = bflo(q.y), t3 = bfhi(q.y), t4 = bflo(q.z), t5 = bfhi(q.z), t6 = bflo(q.w), t7 = bfhi(q.w);
                        ss += (t0 * t0 + t1 * t1) + (t2 * t2 + t3 * t3) + (t4 * t4 + t5 * t5) + (t6 * t6 + t7 * t7); }
                    ss += __shfl_xor(ss, 1); ss += __shfl_xor(ss, 2); ss += __shfl_xor(ss, 4); ss += __shfl_xor(ss, 8);
                    if (cl == 0) RS[row] = rsqrtf(ss * (1.f / D) + EPS);
                }
                LBAR();
                {
#pragma unroll
                    for (int i = 0; i < 8; ++i) { const int row = (lane >> 4) + 4 * i; const float rs = RS[row];
                        const v4u q = *(const LAS v4u*)(T + row * TP + (128 * wave + 8 * (lane & 15)) * 2);
                        v4u o; o.x = pkbf(bflo(q.x) * rs * gq[0] + sq[0], bfhi(q.x) * rs * gq[1] + sq[1]); o.y = pkbf(bflo(q.y) * rs * gq[2] + sq[2], bfhi(q.y) * rs * gq[3] + sq[3]);
                        o.z = pkbf(bflo(q.z) * rs * gq[4] + sq[4], bfhi(q.z) * rs * gq[5] + sq[5]); o.w = pkbf(bflo(q.w) * rs * gq[6] + sq[6], bfhi(q.w) * rs * gq[7] + sq[7]);
                        *(v4u*)(H + (size_t)(m0 + row) * D + 128 * wave + 8 * (lane & 15)) = o; }
                }
                f32x16 acc;
                {
#pragma unroll
                    for (int i = 0; i < 16; ++i) acc[i] = 0.f;
                    const int r32 = lane & 31, hh = lane >> 5;
#pragma unroll
                    for (int st = 0; st < 8; ++st) { const pg8::bf16x8 ah = *(const LAS pg8::bf16x8*)(T + r32 * TP + (128 * wave + 16 * st + 8 * hh) * 2);
                        acc = __builtin_amdgcn_mfma_f32_32x32x16_bf16(ah, wh[st], acc, 0, 0, 0); acc = __builtin_amdgcn_mfma_f32_32x32x16_bf16(ah, wl[st], acc, 0, 0, 0); }
                }
                LBAR();
                float* RED = (float*)(lds + (grp & 1) * TBY);
                { const int r32 = lane & 31, hh = lane >> 5;
#pragma unroll
                    for (int reg = 0; reg < 16; ++reg) RED[(wave * 32 + (reg & 3) + 8 * (reg >> 2) + 4 * hh) * 32 + r32] = acc[reg]; }
                LBAR();
#pragma unroll
                for (int j = 0; j < 2; ++j) {
                    const int row = 4 * wave + 2 * j + (lane >> 5), me = lane & 31, m = m0 + row;
                    float v = 0.f;
#pragma unroll
                    for (int w2 = 0; w2 < 8; ++w2) v += RED[(w2 * 32 + row) * 32 + me];
                    float val = v * RS[row] + CB[b * 32 + me];
                    float tv[4]; int ti[4];
#pragma unroll
                    for (int k2 = 0; k2 < 4; ++k2) { float mx = val;
#pragma unroll
                        for (int o = 1; o < 32; o <<= 1) mx = fmaxf(mx, __shfl_xor(mx, o));
                        int em = (val == mx) ? me : 99;
#pragma unroll
                        for (int o = 1; o < 32; o <<= 1) { const int w3 = __shfl_xor(em, o); em = w3 < em ? w3 : em; }
                        tv[k2] = mx; ti[k2] = em; if (me == em) val = -3.0e38f; }
                    const float e1 = __expf(tv[1] - tv[0]), e2 = __expf(tv[2] - tv[0]), e3 = __expf(tv[3] - tv[0]); const float inv = __builtin_amdgcn_rcpf(1.f + e1 + e2 + e3);
                    if (me < 4) { const int e = me == 0 ? ti[0] : me == 1 ? ti[1] : me == 2 ? ti[2] : ti[3]; const float w = (me == 0 ? 1.f : me == 1 ? e1 : me == 2 ? e2 : e3) * inv;
                        TOPI[(size_t)m * 4 + me] = e; TOPW[(size_t)m * 4 + me] = w;
                        const int lp = atomicAdd(&lcnt[e], 1); const int li = (grp * 32 + row) * 4 + me; lent[li * 3] = (e << 16) | lp; lent[li * 3 + 1] = m * 4 + me; lent[li * 3 + 2] = __builtin_bit_cast(int, w); }
                }
                asm volatile("s_waitcnt vmcnt(0)" ::: "memory");
                LBAR();
            }
            if (tid < 32) lbase[tid] = (int)atomicAdd(&CNT[tid], (unsigned)lcnt[tid]);
            __syncthreads();
            { const int w0 = lent[tid * 3], e = w0 >> 16, lp = w0 & 0xffff; const size_t li = (size_t)e * M + lbase[e] + lp; LIST[li] = lent[tid * 3 + 1]; ((int*)(ws + WS_LISTW))[li] = lent[tid * 3 + 2]; }
            __syncthreads();
        }
#undef P8_DMA
    }
    SEAM(8); }

    for (int rep_ = 0; rep_ < NREP(10); ++rep_) { if (IN(10)) {
        PHASE_PTRS
        int* ts = (int*)(lds + AUX_OFF);
        moe_tile_table(CNT, ts, tid);
        const long L1all = (long)ts[NE] * 8, L1full = (L1all / G) * G;
        SchedMoe S{(const char*)H, (const char*)(ws + WS_W1), ts, LIST, (const float*)(ws + WS_LISTW), ap->in[I_B1], 2048, ts[NE], 8, G, bid, (size_t)2048 * 1024 * 2, true, 0, L1full, false, nullptr, 0u, 0, 8};
        EpiMoe1 E{ACT};
        pg8::gemm_phase<EpiMoe1, SchedMoe, true, true, 2>((LAS unsigned char*)lds, D, S, E, tid, (LAS unsigned char*)lds + 131072);
        __syncthreads();
    }
    SEAM(10); }

    for (int rep_ = 0; rep_ < NREP(11); ++rep_) { if (IN(11)) {
        PHASE_PTRS
        int* ts = (int*)(lds + AUX_OFF);
        moe_tile_table(CNT, ts, tid);
        const long L1all = (long)ts[NE] * 8, L1full = (L1all / G) * G; const int nleft = (int)(L1all - L1full);
        if (bid < nleft) {
            SchedMoe S1{(const char*)H, (const char*)(ws + WS_W1), ts, LIST, (const float*)(ws + WS_LISTW), ap->in[I_B1], 2048, ts[NE], 8, G, bid, (size_t)2048 * 1024 * 2, true, L1full, L1all, false, nullptr, 0u, 0, 8};
            EpiMoe1 E1{ACT};
            pg8::gemm_phase<EpiMoe1, SchedMoe, true, true, 2>((LAS unsigned char*)lds, D, S1, E1, tid, (LAS unsigned char*)lds + 131072);
            asm volatile("s_waitcnt vmcnt(0)" ::: "memory");
            __syncthreads();
            if (tid == 0) { __builtin_amdgcn_fence(__ATOMIC_RELEASE, "agent"); asm volatile("s_waitcnt vmcnt(0)" ::: "memory"); __hip_atomic_fetch_add(ctl + CW_MOE, 1u, RLX_AGENT); }
        }
        SchedMoe S{(const char*)ACT, (const char*)(ws + WS_W2), ts, LIST, (const float*)(ws + WS_LISTW), ap->in[I_B2], 1024, ts[NE], 4, G, (bid - nleft + G) % G, (size_t)1024 * 1024 * 2, false,
                   0, (long)ts[NE] * 4, true, nleft > 0 ? ctl + CW_MOE : nullptr, (unsigned)nleft * (unsigned)(rep_ + 1), L1full, 8};
        EpiMoe2 E{Y};
        pg8::gemm_phase<EpiMoe2, SchedMoe, true, false, 3>((LAS unsigned char*)lds, FF, S, E, tid, (LAS unsigned char*)lds + 131072);
        __syncthreads();
    }
    SEAM(11); }

    for (int rep_ = 0; rep_ < NREP(12); ++rep_) { if (IN(12)) {
        PHASE_PTRS
        const float* nfin = ap->in[I_NFIN];
        for (int m = gw; m < M; m += NGW) {
            const int b = m >> 13; const float* md = MOD + b * 6144 + 5120;
            float v[16]; float ss = 0.f;
#pragma unroll
            for (int c = 0; c < 2; ++c) {
                float mo[8] = {0.f, 0.f, 0.f, 0.f, 0.f, 0.f, 0.f, 0.f};
#pragma unroll
                for (int k2 = 0; k2 < 4; ++k2) { const v4u y = *(const v4u*)(Y + ((size_t)m * 4 + k2) * D + c * 512 + lane * 8);
                    mo[0] += bflo(y.x); mo[1] += bfhi(y.x); mo[2] += bflo(y.y); mo[3] += bfhi(y.y); mo[4] += bflo(y.z); mo[5] += bfhi(y.z); mo[6] += bflo(y.w); mo[7] += bfhi(y.w); }
                const v4u xq = *(const v4u*)(X2 + (size_t)m * D + c * 512 + lane * 8); const f32x4 xa[2] = {(f32x4){bflo(xq.x), bfhi(xq.x), bflo(xq.y), bfhi(xq.y)}, (f32x4){bflo(xq.z), bfhi(xq.z), bflo(xq.w), bfhi(xq.w)}};
#pragma unroll
                for (int q = 0; q < 2; ++q) { const f32x4 xv = xa[q]; const f32x4 gv = *(const f32x4*)(md + c * 512 + lane * 8 + q * 4);
#pragma unroll
                    for (int j = 0; j < 4; ++j) { const float t = xv[j] + gv[j] * mo[q * 4 + j]; v[c * 8 + q * 4 + j] = t; ss += t * t; } }
            }
            const float rstd = rsqrtf(wave_sum(ss) * (1.f / D) + EPS);
#pragma unroll
            for (int c = 0; c < 2; ++c)
#pragma unroll
                for (int q = 0; q < 2; ++q) { const f32x4 nv = *(const f32x4*)(nfin + c * 512 + lane * 8 + q * 4);
                    *(f32x4*)(ap->out + (size_t)m * D + c * 512 + lane * 8 + q * 4) = (f32x4){v[c * 8 + q * 4] * rstd * nv[0], v[c * 8 + q * 4 + 1] * rstd * nv[1], v[c * 8 + q * 4 + 2] * rstd * nv[2], v[c * 8 + q * 4 + 3] * rstd * nv[3]}; }
        }
    }
    if (NREP(12) > 1) xcd_barrier(bar); }
#undef IN
#undef SEAM
}

extern "C" void kernel_launch(void* const* d_in, const int* in_sizes, int n_in, void* d_out, int out_size, void* d_ws, size_t ws_size, hipStream_t stream) {
    static int grid = 0;
    if (grid == 0) {
        if (n_in != 28 || in_sizes[0] != M * D || out_size != M * D || ws_size < WS_END) { fprintf(stderr, "kernel_launch: unexpected shapes/workspace (n_in %d, ws %zu)\n", n_in, ws_size); grid = -1; return; }
        int dev = 0, cus = 0;
        if (hipGetDevice(&dev) != hipSuccess || hipDeviceGetAttribute(&cus, hipDeviceAttributeMultiprocessorCount, dev) != hipSuccess) { grid = -1; return; }
        if (hipFuncSetAttribute((const void*)mk_fwd, hipFuncAttributeMaxDynamicSharedMemorySize, LDS_BYTES) != hipSuccess) { fprintf(stderr, "kernel_launch: hipFuncSetAttribute failed\n"); grid = -1; return; }
        int per_cu = 0;
        if (hipOccupancyMaxActiveBlocksPerMultiprocessor(&per_cu, (const void*)mk_fwd, NTHR, LDS_BYTES) != hipSuccess || per_cu < 1) fprintf(stderr, "kernel_launch: occupancy query reports %d\n", per_cu);
        (void)hipGetLastError();
        grid = cus;
    }
    if (grid < 0) return;
    if (hipMemsetAsync((char*)d_ws + WS_CTL, 0, CTL_ZERO_BYTES, stream) != hipSuccess) return;
    Args a{};
    for (int i = 0; i < 28; ++i) a.in[i] = (const float*)d_in[i];
    a.out = (float*)d_out; a.ws = (unsigned char*)d_ws;
    for (int li = 0; li < N_LAUNCHES; ++li) {
        a.ph_lo = (N_LAUNCHES == 1) ? 0 : li; a.ph_hi = (N_LAUNCHES == 1) ? NPH : li + 1; a.li = li; a.pad = 0;
        hipLaunchKernelGGL(mk_fwd, dim3(grid), dim3(NTHR), LDS_BYTES, stream, a);
        if (hipPeekAtLastError() != hipSuccess) { fprintf(stderr, "kernel_launch: launch %d failed\n", li); break; }
    }
}
```
